# Optimizing an MI355X kernel written in HIP

```python
import math
import jax, jax.numpy as jnp
from jax import lax
import numpy as np

D_MODEL = 1024
BATCH = 8
SEQ = 2048
DEPTH = 2

MIX_WIDTH = D_MODEL
A_HEADS = 4
A_HEAD_DIM = MIX_WIDTH // 2 // A_HEADS
A_WIDTH = A_HEADS * A_HEAD_DIM
B_HEADS = 4
B_HEAD_DIM = MIX_WIDTH // 2 // B_HEADS
B_WIDTH = B_HEADS * B_HEAD_DIM
IN_AB = A_WIDTH + 2 * B_WIDTH
CONV_WIDTH = 31
POOL_WINDOWS = (2, 4, 8, 16)
C_GROUPS = len(POOL_WINDOWS)
C_GROUP_DIM = D_MODEL // C_GROUPS
D_FF = int(math.ceil((8 * D_MODEL / 3) / 256) * 256)
N_EVEN = (DEPTH + 1) // 2
N_ODD = DEPTH // 2
RMS_EPS = 1e-6
LN_EPS = 1e-5

kernel_name = "hybrid_fnet_conformer_poolformer_encoder"


def rmsnorm(x, g):
    xf = x.astype(jnp.float32)
    inv = lax.rsqrt(jnp.mean(xf * xf, axis=-1, keepdims=True) + RMS_EPS)
    return (xf * inv).astype(x.dtype) * g


def layernorm(x, g, b):
    xf = x.astype(jnp.float32)
    mu = jnp.mean(xf, axis=-1, keepdims=True)
    var = jnp.mean(jnp.square(xf - mu), axis=-1, keepdims=True)
    return ((xf - mu) * lax.rsqrt(var + LN_EPS)).astype(x.dtype) * g + b


def swiglu_ffn(h, w_gate, w_up, w_down):
    return (jax.nn.silu(h @ w_gate) * (h @ w_up)) @ w_down


def fnet_heads(a, fnet_map):
    bsz, seq, _ = a.shape
    a4 = a.reshape(bsz, seq, A_HEADS, A_HEAD_DIM).astype(jnp.float32)
    f = jnp.fft.fft2(a4, axes=(1, 3), norm="ortho").real.astype(a.dtype)
    y = jnp.einsum("bshd,hde->bshe", f, fnet_map)
    return y.reshape(bsz, seq, A_WIDTH)


def conformer_conv_heads(v, gate, conv_w, conv_b, ln_g, ln_b):
    u = v * jax.nn.sigmoid(gate)
    pad = CONV_WIDTH // 2
    u = lax.conv_general_dilated(
        u, conv_w[:, None, :].astype(u.dtype),
        window_strides=(1,), padding=[(pad, pad)],
        dimension_numbers=("NWC", "WIO", "NWC"),
        feature_group_count=B_WIDTH) + conv_b
    bsz, seq, _ = u.shape
    u = u.reshape(bsz, seq, B_HEADS, B_HEAD_DIM)
    u = layernorm(u, ln_g.reshape(B_HEADS, B_HEAD_DIM), ln_b.reshape(B_HEADS, B_HEAD_DIM))
    return jax.nn.silu(u).reshape(bsz, seq, B_WIDTH)


def centred_pool_minus_self(u, window):
    seq = u.shape[1]
    uf = u.astype(jnp.float32)
    cs = jnp.concatenate([jnp.zeros_like(uf[:, :1]), lax.cumsum(uf, axis=1)], axis=1)
    pos = jnp.arange(seq, dtype=jnp.int32)
    lo = jnp.clip(pos - window // 2, 0, seq)
    hi = jnp.clip(pos - window // 2 + window, 0, seq)
    win_sum = jnp.take(cs, hi, axis=1) - jnp.take(cs, lo, axis=1)
    cnt = (hi - lo).astype(jnp.float32)[None, :, None]
    return (win_sum / cnt - uf).astype(u.dtype)


def pool_mixer(h, pool_map, pool_scale):
    outs = []
    for gi, w in enumerate(POOL_WINDOWS):
        hg = h[..., gi * C_GROUP_DIM:(gi + 1) * C_GROUP_DIM]
        pg = centred_pool_minus_self(hg, w)
        outs.append(pg @ pool_map[gi])
    return jnp.concatenate(outs, axis=-1) * pool_scale


def setup_inputs(seed: int = 0) -> dict:
    key = jax.random.key(seed)
    ks = jax.random.split(key, 20)
    f32 = jnp.float32
    nrm = lambda k, shape, fan_in: jax.random.normal(k, shape, f32) * (fan_in ** -0.5)
    gain = lambda k, shape: 1.0 + 0.05 * jax.random.normal(k, shape, f32)
    return {
        "x": jax.random.normal(ks[0], (BATCH, SEQ, D_MODEL), f32),
        "norm_mix_g": gain(ks[1], (DEPTH, D_MODEL)),
        "norm_ffn_g": gain(ks[2], (DEPTH, D_MODEL)),
        "w_in_ab": nrm(ks[3], (N_EVEN, D_MODEL, IN_AB), D_MODEL),
        "fnet_map": nrm(ks[4], (N_EVEN, A_HEADS, A_HEAD_DIM, A_HEAD_DIM), A_HEAD_DIM),
        "conv_w": nrm(ks[5], (N_EVEN, CONV_WIDTH, B_WIDTH), CONV_WIDTH),
        "conv_b": 0.02 * jax.random.normal(ks[6], (N_EVEN, B_WIDTH), f32),
        "conv_ln_g": gain(ks[7], (N_EVEN, B_WIDTH)),
        "conv_ln_b": 0.02 * jax.random.normal(ks[8], (N_EVEN, B_WIDTH), f32),
        "w_out_ab": nrm(ks[9], (N_EVEN, MIX_WIDTH, D_MODEL), MIX_WIDTH),
        "pool_map": nrm(ks[10], (N_ODD, C_GROUPS, C_GROUP_DIM, C_GROUP_DIM), C_GROUP_DIM),
        "pool_scale": 1.0 + 0.1 * jax.random.normal(ks[11], (N_ODD, D_MODEL), f32),
        "ffn_w_gate": nrm(ks[12], (DEPTH, D_MODEL, D_FF), D_MODEL),
        "ffn_w_up": nrm(ks[13], (DEPTH, D_MODEL, D_FF), D_MODEL),
        "ffn_w_down": nrm(ks[14], (DEPTH, D_FF, D_MODEL), D_FF),
        "final_g": gain(ks[15], (D_MODEL,)),
    }


def reference(x, norm_mix_g, norm_ffn_g, w_in_ab, fnet_map, conv_w, conv_b, conv_ln_g,
              conv_ln_b, w_out_ab, pool_map, pool_scale, ffn_w_gate, ffn_w_up, ffn_w_down,
              final_g):
    for layer in range(DEPTH):
        h = rmsnorm(x, norm_mix_g[layer])
        if layer % 2 == 0:
            e = layer // 2
            p = h @ w_in_ab[e]
            ya = fnet_heads(p[..., :A_WIDTH], fnet_map[e])
            yb = conformer_conv_heads(p[..., A_WIDTH:A_WIDTH + B_WIDTH],
                                      p[..., A_WIDTH + B_WIDTH:],
                                      conv_w[e], conv_b[e], conv_ln_g[e], conv_ln_b[e])
            y = jnp.concatenate([ya, yb], axis=-1) @ w_out_ab[e]
        else:
            o = layer // 2
            y = pool_mixer(h, pool_map[o], pool_scale[o])
        x = x + y
        h = rmsnorm(x, norm_ffn_g[layer])
        x = x + swiglu_ffn(h, ffn_w_gate[layer], ffn_w_up[layer], ffn_w_down[layer])
    return rmsnorm(x, final_g)
```

```cpp
#include <hip/hip_runtime.h>
#include <cstdio>
#include <cstdint>

#ifndef MK_SPLIT
#define MK_SPLIT 0
#endif

#define LAS __attribute__((address_space(3)))
#define GAS __attribute__((address_space(1)))
typedef unsigned short bf16_t;
typedef short bf16x8 __attribute__((ext_vector_type(8)));
typedef float f32x4 __attribute__((ext_vector_type(4)));
typedef float f32x2 __attribute__((ext_vector_type(2)));
typedef unsigned u32x4 __attribute__((ext_vector_type(4)));
typedef unsigned u32x2 __attribute__((ext_vector_type(2)));
typedef GAS unsigned gu32;

constexpr int BATCH = 8, SEQ = 2048, D = 1024, MTOK = BATCH * SEQ;
constexpr int INAB = 1536, DFF = 2816, KOUT = 1536;
constexpr float RMS_EPS = 1e-6f, LN_EPS = 1e-5f;
constexpr int NWAVES = 8;
constexpr int N_PHASES = 11;

constexpr size_t MiB = 1u << 20;
constexpr size_t WS_CTL = 0, CTL_ZERO_BYTES = 1 * MiB;
constexpr size_t WS_SSQ = 1 * MiB;
constexpr size_t WS_WIN = 5 * MiB;
constexpr size_t WS_WO = 8 * MiB;
constexpr size_t WS_WGU = 11 * MiB;
constexpr size_t WS_WD = 33 * MiB;
constexpr size_t WS_PM = 44 * MiB;
constexpr size_t WS_DM = 45 * MiB;
constexpr size_t WS_XBA = 61 * MiB;
constexpr size_t WS_XBB = 93 * MiB;
constexpr size_t WS_AT = 125 * MiB;
constexpr size_t WS_U = 141 * MiB;
constexpr size_t WS_YQ = 157 * MiB;
constexpr size_t WS_HID = 125 * MiB;
constexpr size_t WS_END = 213 * MiB;
constexpr int CW_BAR = 4096;

constexpr int RING_BYTES = 131072;
constexpr int LDSCTL_OFF = RING_BYTES, MISC_OFF = LDSCTL_OFF + 320;
constexpr int LDS_BYTES = 147456;

#define LDS_WAIT() asm volatile("s_waitcnt lgkmcnt(0)" ::: "memory")
#define VM_WAIT() asm volatile("s_waitcnt vmcnt(0)" ::: "memory")
__device__ __forceinline__ unsigned f2bf(float f) { unsigned u = __builtin_bit_cast(unsigned, f); return (u + 0x7fffu + ((u >> 16) & 1u)) >> 16; }
__device__ __forceinline__ unsigned pk2(float lo, float hi) { return f2bf(lo) | (f2bf(hi) << 16); }
__device__ __forceinline__ unsigned cvt_pk_bf16(float lo, float hi) { unsigned r; asm volatile("v_cvt_pk_bf16_f32 %0, %1, %2" : "=v"(r) : "v"(lo), "v"(hi)); return r; }
__device__ __forceinline__ float bf_lo(unsigned w) { return __builtin_bit_cast(float, w << 16); }
__device__ __forceinline__ float bf_hi(unsigned w) { return __builtin_bit_cast(float, w & 0xffff0000u); }
__device__ __forceinline__ float wave_sum(float v) {
#pragma unroll
    for (int o = 1; o < 64; o <<= 1) v += __shfl_xor(v, o);
    return v;
}
__device__ __forceinline__ float fast_sigmoid(float g) { return __builtin_amdgcn_rcpf(1.0f + __builtin_amdgcn_exp2f(g * -1.44269504089f)); }

#define XB_TMO      128
#define XB_XCNT(j)  (256  + 64 * (j))
#define XB_XSUB(j)  (1280 + 64 * (j))
#define XB_XGEN(j)  (2304 + 64 * (j))
#define XB_TOP      3328
#define XB_TOPGEN   3392
#define XCD_BAR_WORDS 3456
#define XB_SPIN_CAP (1u << 18)
__device__ __forceinline__ unsigned xb_ld(unsigned* p)              { return __hip_atomic_load(p, __ATOMIC_RELAXED, __HIP_MEMORY_SCOPE_AGENT); }
__device__ __forceinline__ unsigned xb_add(unsigned* p, unsigned v) { return __hip_atomic_fetch_add(p, v, __ATOMIC_RELAXED, __HIP_MEMORY_SCOPE_AGENT); }
__device__ __forceinline__ unsigned xb_xcc_id() { return (unsigned)__builtin_amdgcn_s_getreg((3 << 11) | 20) & 0xFu; }
#define XB_SPIN(cond, bar) do { unsigned _sp = 0; while (cond) { __builtin_amdgcn_s_sleep(1); \
    if ((++_sp & 255u) == 0u) { if (xb_ld(&(bar)[XB_TMO])) break; if (_sp > XB_SPIN_CAP) { atomicAdd(&(bar)[XB_TMO], 1u); break; } } } } while (0)
struct XcdBarrier { unsigned* bar; unsigned x; volatile LAS unsigned* st; };
__device__ __forceinline__ XcdBarrier xcd_barrier_post(unsigned* bar, volatile LAS unsigned* st) {
    XcdBarrier b; b.bar = bar; b.x = xb_xcc_id(); b.st = st;
    if (threadIdx.x == 0) (void)xb_add(&bar[XB_XCNT(b.x)], 1u);
    return b;
}
__device__ __forceinline__ void xcd_barrier_complete(unsigned* bar, unsigned x, unsigned& nloc, unsigned& nx) {
    const unsigned G = gridDim.x * gridDim.y * gridDim.z;
    unsigned sum, cnt, mine, sp = 0u;
    for (;;) {
        sum = 0u; cnt = 0u; mine = 0u;
#pragma unroll
        for (unsigned j = 0; j < 16; ++j) { const unsigned c = xb_ld(&bar[XB_XCNT(j)]); sum += c; cnt += (c > 0u) ? 1u : 0u; mine = (j == x) ? c : mine; }
        if (sum == G) break;
        __builtin_amdgcn_s_sleep(1);
        if ((++sp & 255u) == 0u) { if (xb_ld(&bar[XB_TMO])) break; if (sp > XB_SPIN_CAP) { atomicAdd(&bar[XB_TMO], 1u); break; } }
    }
    nloc = mine > 0u ? mine : 1u; nx = cnt > 0u ? cnt : 1u;
}
template <bool FIRST>
__device__ __forceinline__ void xcd_barrier(const XcdBarrier& b) {
    asm volatile("s_waitcnt vmcnt(0)" ::: "memory");
    __syncthreads();
    if (threadIdx.x == 0) {
        unsigned* bar = b.bar;
        __builtin_amdgcn_s_waitcnt(0);
        unsigned nloc = b.st[0], nx = b.st[1];
        if (FIRST) { xcd_barrier_complete(bar, b.x, nloc, nx); b.st[0] = nloc; b.st[1] = nx; }
        const unsigned old = xb_add(&bar[XB_XSUB(b.x)], 1u);
        const unsigned gen = old / nloc;
        if (old + 1u == (gen + 1u) * nloc) {
            __builtin_amdgcn_fence(__ATOMIC_RELEASE, "agent");
            asm volatile("s_waitcnt vmcnt(0)" ::: "memory");
            const unsigned og = xb_add(&bar[XB_TOP], 1u);
            const unsigned tg = og / nx;
            if (og + 1u == (tg + 1u) * nx) xb_add(&bar[XB_TOPGEN], 1u);
            else XB_SPIN(xb_ld(&bar[XB_TOPGEN]) == tg, bar);
            __builtin_amdgcn_fence(__ATOMIC_ACQUIRE, "agent");
            xb_add(&bar[XB_XGEN(b.x)], 1u);
            asm volatile("s_waitcnt vmcnt(0)" ::: "memory");
        } else {
            XB_SPIN(xb_ld(&bar[XB_XGEN(b.x)]) == gen, bar);
            __builtin_amdgcn_fence(__ATOMIC_ACQUIRE, "agent");
            asm volatile("s_waitcnt vmcnt(0)" ::: "memory");
        }
    }
    __syncthreads();
}

namespace pg8 {
constexpr int BM = 256, BK = 64, HALF = 128, HTB = HALF * BK * 2, STAGE_BYTES = 8 * HTB, NXCD = 8, WGM = 8;
__host__ __device__ __forceinline__ int lds_byte(int r, int c) { const int st = (r >> 4) * 2 + (c >> 5), rr = r & 15, cc = c & 31, ob = rr * 64 + cc * 2; return st * 1024 + (ob ^ (((ob >> 9) & 1) << 5)); }
__host__ __device__ __forceinline__ void stage_rc(int b, int& R, int& C) { const int st = b / 1024, sb = b % 1024, swz = sb ^ (((sb >> 9) & 1) << 5); R = (st >> 1) * 16 + swz / 64; C = (st & 1) * 32 + (swz % 64) / 2; }
__host__ __device__ __forceinline__ int perm32(int rho) { const int n = rho >> 4, i = rho & 15; return 8 * (i >> 2) + 4 * n + (i & 3); }
struct Unit { int pm, pn; };
struct Order {
    int nM, nN, nwg, G, c;
    __device__ __forceinline__ void init(int nM_, int nN_, int G_, int c_) { nM = nM_; nN = nN_; nwg = nM * nN; G = G_; c = c_; }
    __device__ __forceinline__ bool next(int i, Unit& u) const {
        const long L = (long)i * G + c; if (L >= nwg) return false;
        int wgid = (int)L; { const int q = nwg / NXCD, r = nwg % NXCD, xcd = wgid % NXCD, off = wgid / NXCD; wgid = (xcd < r ? xcd * (q + 1) : r * (q + 1) + (xcd - r) * q) + off; }
        const int nig = WGM * nN, gid = wgid / nig, fm = gid * WGM, gsz = (nM - fm) < WGM ? (nM - fm) : WGM;
        u.pm = fm + ((wgid % nig) % gsz); u.pn = (wgid % nig) / gsz; return true;
    }
};
template <class P, bool ALIGN_EPI>
__device__ __forceinline__ void gemm_phase(LAS unsigned char* lds, const P& p) {
    const int tid = threadIdx.x, wid = __builtin_amdgcn_readfirstlane(tid >> 6), lane = tid & 63, wr = wid >> 2, wc = wid & 3, fr = lane & 15, fq = lane >> 4;
    const int K = p.K, nt = K / BK;
    unsigned voffA[2], voffB[2];
#pragma unroll
    for (int i = 0; i < 2; ++i) { int R, C; stage_rc(tid * 16 + i * 8192, R, C); const int Rb = P::PERM ? ((R & ~31) + perm32(R & 31)) : R;
        voffA[i] = (unsigned)(R * p.lda + C) * 2u; voffB[i] = (unsigned)(Rb * p.ldb + C) * 2u; }
    const size_t kstep = (size_t)(BK * 2);
    const size_t hstepA = (size_t)HALF * p.lda * 2, hstepB = (size_t)HALF * p.ldb * 2;
    const unsigned ldsw = (unsigned)wid * 1024u;
    const int aoff = lds_byte(wr * 64 + fr, fq * 8), boff = lds_byte(wc * 32 + fr, fq * 8);
#define PG8_SA(b, h) (((b) * 2 + (h)) * HTB)
#define PG8_SB(b, h) ((4 + (b) * 2 + (h)) * HTB)
#define PG8_STAGE(bufoff, gbase, voff) do { _Pragma("unroll") for (int _i = 0; _i < 2; ++_i) \
        __builtin_amdgcn_global_load_lds((const unsigned*)((const char*)(gbase) + (voff)[_i]), (LAS unsigned*)(lds + (bufoff) + ldsw + _i * 8192), 16, 0, 0); } while (0)
#define PG8_LDA(dst, b, h) do { _Pragma("unroll") for (int m = 0; m < 4; ++m) _Pragma("unroll") for (int k = 0; k < 2; ++k) dst[m][k] = *(const LAS bf16x8*)(lds + PG8_SA(b, h) + aoff + m * 2048 + k * 1024); } while (0)
#define PG8_LDB(dst, b, h) do { _Pragma("unroll") for (int n = 0; n < 2; ++n) _Pragma("unroll") for (int k = 0; k < 2; ++k) dst[n][k] = *(const LAS bf16x8*)(lds + PG8_SB(b, h) + boff + n * 2048 + k * 1024); } while (0)
#define PG8_MMA(ai, bj, At, Bt) do { __builtin_amdgcn_s_setprio(1); _Pragma("unroll") for (int m = 0; m < 4; ++m) _Pragma("unroll") for (int n = 0; n < 2; ++n) _Pragma("unroll") for (int k = 0; k < 2; ++k) \
        acc[ai][bj][m][n] = __builtin_amdgcn_mfma_f32_16x16x32_bf16(Bt[n][k], At[m][k], acc[ai][bj][m][n], 0, 0, 0); __builtin_amdgcn_s_setprio(0); } while (0)
#define PG8_WAIT_V(n) asm volatile("s_waitcnt vmcnt(" #n ")" ::: "memory")
#define PG8_WAIT_L(n) asm volatile("s_waitcnt lgkmcnt(" #n ")" ::: "memory")
#define PG8_BAR __builtin_amdgcn_s_barrier()
#define PG8_SCHED __builtin_amdgcn_sched_barrier(0)
    Unit cur, nxt; int ui = 0;
    if (!p.next(0, cur)) return;
    f32x4 acc[2][2][4][2];
#pragma unroll
    for (int a = 0; a < 2; ++a)
#pragma unroll
        for (int b = 0; b < 2; ++b)
#pragma unroll
            for (int m = 0; m < 4; ++m)
#pragma unroll
                for (int n = 0; n < 2; ++n) acc[a][b][m][n] = (f32x4){0.f, 0.f, 0.f, 0.f};
    bf16x8 At[4][2], B0[2][2], B1[2][2];
    const char* cA = p.aptr(cur); const char* cB = p.bptr(cur);
    PG8_STAGE(PG8_SB(0, 0), cB, voffB); PG8_STAGE(PG8_SB(0, 1), cB + hstepB, voffB); PG8_STAGE(PG8_SA(0, 0), cA, voffA); PG8_STAGE(PG8_SA(0, 1), cA + hstepA, voffA);
    if (wr == 1) PG8_BAR;
    PG8_WAIT_V(2); PG8_BAR;
    PG8_STAGE(PG8_SB(1, 0), cB + kstep, voffB); PG8_STAGE(PG8_SA(1, 0), cA + kstep, voffA); PG8_STAGE(PG8_SB(1, 1), cB + hstepB + kstep, voffB);
    PG8_WAIT_V(6); PG8_BAR;
    for (;;) {
        const bool has_next = p.next(ui + 1, nxt);
        const char* nA = has_next ? p.aptr(nxt) : cA; const char* nB = has_next ? p.bptr(nxt) : cB;
        for (int t = 0; t < nt; t += 2) {
            const bool last = (t == nt - 2);
            const char* a1 = cA + (size_t)(t + 1) * kstep;
            const char* a2 = last ? nA : cA + (size_t)(t + 2) * kstep; const char* b2 = last ? nB : cB + (size_t)(t + 2) * kstep;
            const char* a3 = a2 + kstep; const char* b3 = b2 + kstep;
            PG8_LDB(B0, 0, 0); PG8_LDB(B1, 0, 1); PG8_SCHED; PG8_LDA(At, 0, 0); PG8_STAGE(PG8_SA(1, 1), a1 + hstepA, voffA);
            PG8_WAIT_V(8); PG8_WAIT_L(0); PG8_BAR; PG8_MMA(0, 0, At, B0); PG8_MMA(0, 1, At, B1); PG8_BAR; PG8_SCHED;
            PG8_LDA(At, 0, 1); PG8_STAGE(PG8_SB(0, 0), b2, voffB); PG8_STAGE(PG8_SB(0, 1), b2 + hstepB, voffB); PG8_STAGE(PG8_SA(0, 0), a2, voffA);
            PG8_WAIT_V(8); PG8_WAIT_L(0); PG8_BAR; PG8_MMA(1, 0, At, B0); PG8_MMA(1, 1, At, B1); PG8_BAR; PG8_SCHED;
            PG8_LDB(B0, 1, 0); PG8_LDB(B1, 1, 1); PG8_SCHED; PG8_LDA(At, 1, 0); PG8_STAGE(PG8_SA(0, 1), a2 + hstepA, voffA);
            PG8_WAIT_V(8); PG8_WAIT_L(0); PG8_BAR; PG8_MMA(0, 0, At, B0); PG8_MMA(0, 1, At, B1); PG8_BAR; PG8_SCHED;
            PG8_LDA(At, 1, 1); PG8_STAGE(PG8_SB(1, 0), b3, voffB); PG8_STAGE(PG8_SB(1, 1), b3 + hstepB, voffB); PG8_STAGE(PG8_SA(1, 0), a3, voffA);
            PG8_WAIT_V(8); PG8_WAIT_L(0); PG8_BAR; PG8_MMA(1, 0, At, B0); PG8_MMA(1, 1, At, B1); PG8_BAR; PG8_SCHED;
        }
        if constexpr (ALIGN_EPI) { if (wr == 0) PG8_BAR; }
        p.epi(acc, cur, wr, wc, fr, fq);
        if (!has_next) break;
#pragma unroll
        for (int a = 0; a < 2; ++a)
#pragma unroll
            for (int b = 0; b < 2; ++b)
#pragma unroll
                for (int m = 0; m < 4; ++m)
#pragma unroll
                    for (int n = 0; n < 2; ++n) acc[a][b][m][n] = (f32x4){0.f, 0.f, 0.f, 0.f};
        cur = nxt; cA = nA; cB = nB; ++ui;
        if constexpr (ALIGN_EPI) { if (wr == 1) PG8_BAR; }
    }
    PG8_WAIT_V(0);
    if constexpr (!ALIGN_EPI) { if (wr == 0) PG8_BAR; }
    PG8_BAR;
#undef PG8_SA
#undef PG8_SB
#undef PG8_STAGE
#undef PG8_LDA
#undef PG8_LDB
#undef PG8_MMA
#undef PG8_WAIT_V
#undef PG8_WAIT_L
#undef PG8_BAR
#undef PG8_SCHED
}

__device__ __forceinline__ u32x4 pack8(const f32x4 v0, const f32x4 v1) {
    u32x4 w; w.x = cvt_pk_bf16(v0[0], v0[1]); w.y = cvt_pk_bf16(v0[2], v0[3]); w.z = cvt_pk_bf16(v1[0], v1[1]); w.w = cvt_pk_bf16(v1[2], v1[3]); return w;
}

struct ProbIn : Order {
    static constexpr bool PERM = true;
    int K, lda, ldb;
    const bf16_t* X; const bf16_t* WinT; bf16_t* AT; bf16_t* U;
    __device__ __forceinline__ const char* aptr(const Unit& u) const { return u.pn < 2 ? (const char*)(WinT + (size_t)u.pn * 256 * 1024) : (const char*)(X + (size_t)u.pm * 256 * 1024); }
    __device__ __forceinline__ const char* bptr(const Unit& u) const { return u.pn < 2 ? (const char*)(X + (size_t)u.pm * 256 * 1024) : (const char*)(WinT + (size_t)(512 + (u.pn - 2) * 256) * 1024); }
    __device__ __forceinline__ void epi(const f32x4 (&acc)[2][2][4][2], const Unit& u, int wr, int wc, int fr, int fq) const {
        if (u.pn < 2) {
            const int tokc = u.pm * 256 + wc * 32 + 8 * fq;
#pragma unroll
            for (int ai = 0; ai < 2; ++ai)
#pragma unroll
                for (int m = 0; m < 4; ++m) { const int np = u.pn * 256 + ai * 128 + wr * 64 + m * 16 + fr;
#pragma unroll
                    for (int bj = 0; bj < 2; ++bj) { const int tok = tokc + bj * 128, b = tok >> 11, s = tok & 2047;
                        *(u32x4*)(AT + ((size_t)(b * 512 + np) * 2048 + s)) = pack8(acc[ai][bj][m][0], acc[ai][bj][m][1]); } }
        } else {
            const int ch0 = (u.pn - 2) * 128 + wc * 32 + 8 * fq;
#pragma unroll
            for (int ai = 0; ai < 2; ++ai)
#pragma unroll
                for (int m = 0; m < 4; ++m) { const int row = u.pm * 256 + ai * 128 + wr * 64 + m * 16 + fr;
                    f32x4 o0, o1;
#pragma unroll
                    for (int j = 0; j < 4; ++j) { o0[j] = acc[ai][0][m][0][j] * fast_sigmoid(acc[ai][1][m][0][j]); o1[j] = acc[ai][0][m][1][j] * fast_sigmoid(acc[ai][1][m][1][j]); }
                    *(u32x4*)(U + (size_t)row * 512 + ch0) = pack8(o0, o1); }
        }
    }
};
struct ProbDft : Order {
    static constexpr bool PERM = true;
    int K, lda, ldb;
    const bf16_t* DM; const bf16_t* AT; bf16_t* YQ;
    __device__ __forceinline__ const char* aptr(const Unit& u) const { return (const char*)(DM + (size_t)u.pm * 256 * 2048); }
    __device__ __forceinline__ const char* bptr(const Unit& u) const { return (const char*)(AT + (size_t)u.pn * 256 * 2048); }
    __device__ __forceinline__ void epi(const f32x4 (&acc)[2][2][4][2], const Unit& u, int wr, int wc, int fr, int fq) const {
        const int cs = u.pm >> 3, b = u.pn >> 1, n0 = (u.pn & 1) * 256 + wc * 32 + 8 * fq;
#pragma unroll
        for (int ai = 0; ai < 2; ++ai)
#pragma unroll
            for (int m = 0; m < 4; ++m) { const int k = (u.pm & 7) * 256 + ai * 128 + wr * 64 + m * 16 + fr;
                bf16_t* rowp = YQ + (size_t)(b * 2048 + k) * KOUT + cs * 512 + n0;
#pragma unroll
                for (int bj = 0; bj < 2; ++bj) *(u32x4*)(rowp + bj * 128) = pack8(acc[ai][bj][m][0], acc[ai][bj][m][1]); }
    }
};
struct ProbRes : Order {
    static constexpr bool PERM = true;
    int K, lda, ldb;
    const bf16_t* A; const bf16_t* Bt; size_t a_pm, a_pn, b_pn;
    const float* base; float* out; bf16_t* xb; const float* scale; float* ssq;
    __device__ __forceinline__ const char* aptr(const Unit& u) const { return (const char*)(A + (size_t)u.pm * a_pm + (size_t)u.pn * a_pn); }
    __device__ __forceinline__ const char* bptr(const Unit& u) const { return (const char*)(Bt + (size_t)u.pn * b_pn); }
    __device__ __forceinline__ void epi(const f32x4 (&acc)[2][2][4][2], const Unit& u, int wr, int wc, int fr, int fq) const {
        const int col0 = u.pn * 256 + wc * 32 + 8 * fq;
        f32x4 sc[2][2];
#pragma unroll
        for (int bj = 0; bj < 2; ++bj)
#pragma unroll
            for (int n = 0; n < 2; ++n) sc[bj][n] = scale ? *(const f32x4*)(scale + col0 + bj * 128 + 4 * n) : (f32x4){1.f, 1.f, 1.f, 1.f};
#pragma unroll
        for (int ai = 0; ai < 2; ++ai)
#pragma unroll
            for (int m = 0; m < 4; ++m) { const int row = u.pm * 256 + ai * 128 + wr * 64 + m * 16 + fr; const size_t off = (size_t)row * D + col0;
                float sq = 0.f;
#pragma unroll
                for (int bj = 0; bj < 2; ++bj) {
                    const f32x4 b0 = *(const f32x4*)(base + off + bj * 128), b1 = *(const f32x4*)(base + off + bj * 128 + 4);
                    const f32x4 o0 = b0 + acc[ai][bj][m][0] * sc[bj][0], o1 = b1 + acc[ai][bj][m][1] * sc[bj][1];
                    *(f32x4*)(out + off + bj * 128) = o0; *(f32x4*)(out + off + bj * 128 + 4) = o1;
                    if (xb) *(u32x4*)(xb + off + bj * 128) = pack8(o0, o1);
                    sq += (o0[0] * o0[0] + o0[1] * o0[1]) + (o0[2] * o0[2] + o0[3] * o0[3]) + (o1[0] * o1[0] + o1[1] * o1[1]) + (o1[2] * o1[2] + o1[3] * o1[3]);
                }
                sq += __shfl_xor(sq, 16); sq += __shfl_xor(sq, 32);
                if (fq == 0) ssq[(size_t)row * 16 + u.pn * 4 + wc] = sq;
                if (m & 1) asm volatile("" ::: "memory"); }
    }
};
struct ProbGlu : Order {
    static constexpr bool PERM = true;
    int K, lda, ldb;
    const bf16_t* A; const bf16_t* Bt; const float* ssq; bf16_t* H;
    __device__ __forceinline__ const char* aptr(const Unit& u) const { return (const char*)(A + (size_t)u.pm * 256 * 1024); }
    __device__ __forceinline__ const char* bptr(const Unit& u) const { return (const char*)(Bt + (size_t)u.pn * 256 * 1024); }
    __device__ __forceinline__ void epi(const f32x4 (&acc)[2][2][4][2], const Unit& u, int wr, int wc, int fr, int fq) const {
        const int ch0 = u.pn * 128 + wc * 32 + 8 * fq;
#pragma unroll
        for (int ai = 0; ai < 2; ++ai)
#pragma unroll
            for (int m = 0; m < 4; ++m) { const int row = u.pm * 256 + ai * 128 + wr * 64 + m * 16 + fr;
                const f32x4* sp = (const f32x4*)(ssq + (size_t)row * 16);
                const f32x4 s0 = sp[0], s1 = sp[1], s2 = sp[2], s3 = sp[3];
                const float tot = ((s0[0] + s0[1]) + (s0[2] + s0[3])) + ((s1[0] + s1[1]) + (s1[2] + s1[3])) + ((s2[0] + s2[1]) + (s2[2] + s2[3])) + ((s3[0] + s3[1]) + (s3[2] + s3[3]));
                const float inv = 1.0f / sqrtf(tot * (1.0f / D) + RMS_EPS);
                f32x4 o0, o1;
#pragma unroll
                for (int j = 0; j < 4; ++j) {
                    const float g0 = acc[ai][0][m][0][j] * inv, u0 = acc[ai][1][m][0][j] * inv, g1 = acc[ai][0][m][1][j] * inv, u1 = acc[ai][1][m][1][j] * inv;
                    o0[j] = g0 * fast_sigmoid(g0) * u0; o1[j] = g1 * fast_sigmoid(g1) * u1; }
                *(u32x4*)(H + (size_t)row * DFF + ch0) = pack8(o0, o1);
                if (m & 1) asm volatile("" ::: "memory"); }
    }
};
}

struct Frame {
    LAS unsigned char* lds;
    volatile LAS unsigned* MISC;
    gu32* ctl;
    int tid, lane, wave, vcu, G;
    const float *x, *norm_mix_g, *norm_ffn_g, *w_in, *fnet_map, *conv_w, *conv_b, *ln_g, *ln_b, *w_out, *pool_map, *pool_scale, *w_gate, *w_up, *w_down, *final_g;
    float* out; float* ssq;
    bf16_t *WinT, *WoT, *WguT, *WdT, *PmT, *DM, *XBa, *XBb, *AT, *U, *YQ, *HID;
};

__device__ __forceinline__ void p0_tr(const float* W, int ldw, int ks0, int cs0, const float* kscale, bf16_t* Dst, int ldd, int dr0, int dc0, LAS float* scr, int lane) {
#pragma unroll 8
    for (int i = 0; i < 32; ++i) { const int kk = 2 * i + (lane >> 5); float v = W[(size_t)(ks0 + kk) * ldw + cs0 + (lane & 31)]; if (kscale) v *= kscale[ks0 + kk]; scr[kk * 33 + (lane & 31)] = v; }
    LDS_WAIT(); asm volatile("" ::: "memory");
    const int c = lane & 7;
#pragma unroll
    for (int j = 0; j < 4; ++j) { const int n = (lane >> 3) + 8 * j; const LAS float* s = scr + (8 * c) * 33 + n;
        u32x4 o; o.x = pk2(s[0 * 33], s[1 * 33]); o.y = pk2(s[2 * 33], s[3 * 33]); o.z = pk2(s[4 * 33], s[5 * 33]); o.w = pk2(s[6 * 33], s[7 * 33]);
        *(GAS u32x4*)(Dst + (size_t)(dr0 + n) * ldd + dc0 + 8 * c) = o; }
    LDS_WAIT(); asm volatile("" ::: "memory");
}
__device__ __forceinline__ void p0_fold_item(Frame& F, int item) {
    const int nb = item & 31, cs = (item >> 5) & 1, h = item >> 6, tid = F.tid;
    LAS float* Ml = (LAS float*)(F.lds);
    LAS float* Wl = Ml + 128 * 129;
    LAS float* Rl = Wl + 128 * 32;
    LAS float* Tl = Rl + 128 * 33;
    const float* Mh = F.fnet_map + (size_t)h * 128 * 128;
    for (int i = tid; i < 128 * 128; i += NWAVES * 64) { const int l = i >> 7, e = i & 127; Ml[l * 129 + e] = Mh[i]; }
    for (int i = tid; i < 128 * 32; i += NWAVES * 64) { const int e = i >> 5, n = i & 31; Wl[i] = F.w_out[(size_t)(h * 128 + e) * D + nb * 32 + n]; }
    if (tid < 128) Tl[tid] = cospif((float)tid * (1.0f / 64.0f));
    __syncthreads();
    { const int l = tid >> 2, ng = (tid & 3) * 8; float r[8];
#pragma unroll
      for (int j = 0; j < 8; ++j) r[j] = 0.f;
      for (int e = 0; e < 128; ++e) { const float mv = Ml[l * 129 + e];
#pragma unroll
          for (int j = 0; j < 8; ++j) r[j] += mv * Wl[e * 32 + ng + j]; }
#pragma unroll
      for (int j = 0; j < 8; ++j) Rl[l * 33 + ng + j] = r[j]; }
    __syncthreads();
    { const int n = tid >> 4, d0 = (tid & 15) * 8; float o[8];
#pragma unroll
      for (int j = 0; j < 8; ++j) o[j] = 0.f;
      const int sh = cs ? 32 : 0;
      for (int l = 0; l < 128; ++l) { const float rv = Rl[l * 33 + n];
#pragma unroll
          for (int j = 0; j < 8; ++j) o[j] += Tl[(l * (d0 + j) - sh) & 127] * rv; }
      const float sc = cs ? (-1.0f / 512.0f) : (1.0f / 512.0f);
      u32x4 w; w.x = pk2(o[0] * sc, o[1] * sc); w.y = pk2(o[2] * sc, o[3] * sc); w.z = pk2(o[4] * sc, o[5] * sc); w.w = pk2(o[6] * sc, o[7] * sc);
      *(GAS u32x4*)(F.WoT + (size_t)(nb * 32 + n) * KOUT + cs * 512 + h * 128 + d0) = w; }
    __syncthreads();
}
__device__ __forceinline__ void p0_prologue(Frame& F) {
    for (int it = F.vcu; it < 256; it += F.G) p0_fold_item(F, it);
    LAS float* scr = (LAS float*)(F.lds + F.wave * 16384);
    const int gw = F.vcu * NWAVES + F.wave, NGW = F.G * NWAVES;
    constexpr int I_IN = 16 * 48, I_WO = 8 * 32, I_GU = 16 * 88, I_D = 44 * 32, I_PM = 4 * 4 * 8;
    constexpr int NITEMS = I_IN + I_WO + 2 * (2 * I_GU + I_D) + I_PM;
    for (int it = gw; it < NITEMS; it += NGW) {
        int r = it;
        if (r < I_IN) { const int kb = r / 48, cb = r % 48, c0 = 32 * cb; int dr;
            if (c0 < 512) dr = c0; else if (c0 < 1024) { const int ch = c0 - 512; dr = 512 + 256 * (ch >> 7) + (ch & 127); } else { const int ch = c0 - 1024; dr = 512 + 256 * (ch >> 7) + 128 + (ch & 127); }
            p0_tr(F.w_in, INAB, 64 * kb, c0, nullptr, F.WinT, 1024, dr, 64 * kb, scr, F.lane); continue; } r -= I_IN;
        if (r < I_WO) { const int kb = r / 32, cb = r % 32; p0_tr(F.w_out, D, 512 + 64 * kb, 32 * cb, nullptr, F.WoT, KOUT, 32 * cb, 1024 + 64 * kb, scr, F.lane); continue; } r -= I_WO;
        constexpr int I_L = 2 * I_GU + I_D;
        if (r < 2 * I_L) { const int l = r / I_L; r -= l * I_L;
            if (r < 2 * I_GU) { const int up = r / I_GU; r -= up * I_GU; const int kb = r / 88, cb = r % 88, ch = 32 * cb;
                p0_tr((up ? F.w_up : F.w_gate) + (size_t)l * D * DFF, DFF, 64 * kb, ch, F.norm_ffn_g + l * D, F.WguT + (size_t)l * 5632 * 1024, 1024, 256 * (ch >> 7) + 128 * up + (ch & 127), 64 * kb, scr, F.lane); }
            else { r -= 2 * I_GU; const int kb = r / 32, cb = r % 32; p0_tr(F.w_down + (size_t)l * DFF * D, D, 64 * kb, 32 * cb, nullptr, F.WdT + (size_t)l * 1024 * DFF, DFF, 32 * cb, 64 * kb, scr, F.lane); }
            continue; }
        r -= 2 * I_L;
        { const int g = r >> 5, q = r & 31, kb = q >> 3, cb = q & 7; p0_tr(F.pool_map + (size_t)g * 65536, 256, 64 * kb, 32 * cb, nullptr, F.PmT + (size_t)g * 65536, 256, 32 * cb, 64 * kb, scr, F.lane); }
    }
    for (int m = gw; m < MTOK; m += NGW) {
        const GAS f32x4* xr = (const GAS f32x4*)(F.x + (size_t)m * D) + F.lane;
        const GAS f32x4* gr = (const GAS f32x4*)(F.norm_mix_g) + F.lane;
        f32x4 v[4]; float s = 0.f;
#pragma unroll
        for (int j = 0; j < 4; ++j) { v[j] = xr[64 * j]; s += (v[j].x * v[j].x + v[j].y * v[j].y) + (v[j].z * v[j].z + v[j].w * v[j].w); }
        const float inv = 1.0f / sqrtf(wave_sum(s) * (1.0f / D) + RMS_EPS);
        GAS unsigned long long* o8 = (GAS unsigned long long*)(F.XBa + (size_t)m * D) + F.lane;
#pragma unroll
        for (int j = 0; j < 4; ++j) { const f32x4 g = gr[64 * j]; o8[64 * j] = (unsigned long long)pk2(v[j].x * inv * g.x, v[j].y * inv * g.y) | ((unsigned long long)pk2(v[j].z * inv * g.z, v[j].w * inv * g.w) << 32); }
    }
    for (int idx = F.vcu * (NWAVES * 64) + F.tid; idx < 4096 * 256; idx += F.G * NWAVES * 64) {
        const int row = idx >> 8, s0 = (idx & 255) * 8, kr = row & 2047; const bool sn = row >= 2048;
        float v[8];
#pragma unroll
        for (int j = 0; j < 8; ++j) { const int ph = (kr * (s0 + j)) & 2047; const float a = (float)ph * (1.0f / 1024.0f); v[j] = sn ? sinpif(a) : cospif(a); }
        u32x4 w; w.x = pk2(v[0], v[1]); w.y = pk2(v[2], v[3]); w.z = pk2(v[4], v[5]); w.w = pk2(v[6], v[7]);
        *(GAS u32x4*)(F.DM + (size_t)row * 2048 + s0) = w;
    }
}

__device__ __forceinline__ void conv_tile(Frame& F, int tile) {
    const int t0 = tile * 64, b = t0 >> 11, s0 = t0 & 2047, tid = F.tid;
    for (int idx = tid; idx < 94 * 64; idx += NWAVES * 64) { const int r = idx >> 6, c16 = idx & 63, s = s0 - 15 + r;
        u32x4 v = (u32x4){0u, 0u, 0u, 0u};
        if (s >= 0 && s < SEQ) v = *(const GAS u32x4*)(F.U + (size_t)(b * SEQ + s) * 512 + c16 * 8);
        *(LAS u32x4*)(F.lds + r * 1024 + c16 * 16) = v; }
    __syncthreads();
    const int hh = F.wave & 3, th = F.wave >> 2, c = hh * 128 + 2 * F.lane;
    f32x2 w[31];
#pragma unroll
    for (int j = 0; j < 31; ++j) w[j] = *(const GAS f32x2*)(F.conv_w + j * 512 + c);
    const f32x2 cb = *(const GAS f32x2*)(F.conv_b + c), lg = *(const GAS f32x2*)(F.ln_g + c), lb = *(const GAS f32x2*)(F.ln_b + c);
    for (int chunk = 0; chunk < 2; ++chunk) {
        const int tb = th * 32 + chunk * 16;
        f32x2 acc[16];
#pragma unroll
        for (int t = 0; t < 16; ++t) acc[t] = cb;
#pragma unroll
        for (int rr = 0; rr < 46; ++rr) {
            const unsigned pv = *(const LAS unsigned*)(F.lds + (tb + rr) * 1024 + c * 2);
            const f32x2 v = (f32x2){bf_lo(pv), bf_hi(pv)};
#pragma unroll
            for (int t = 0; t < 16; ++t) { const int j = rr - t; if (j >= 0 && j < 31) acc[t] += w[j] * v; }
        }
#pragma unroll
        for (int t = 0; t < 16; ++t) {
            const float mean = wave_sum(acc[t].x + acc[t].y) * (1.0f / 128.0f);
            const float dx = acc[t].x - mean, dy = acc[t].y - mean;
            const float var = wave_sum(dx * dx + dy * dy) * (1.0f / 128.0f);
            const float rstd = 1.0f / sqrtf(var + LN_EPS);
            const float y0 = dx * rstd * lg.x + lb.x, y1 = dy * rstd * lg.y + lb.y;
            const float o0 = y0 * fast_sigmoid(y0), o1 = y1 * fast_sigmoid(y1);
            *(GAS unsigned*)(F.YQ + (size_t)(t0 + tb + t) * KOUT + 1024 + c) = pk2(o0, o1);
        }
    }
    __syncthreads();
}

__device__ __forceinline__ void pool_tile(Frame& F, int tile, const float* ssq) {
    const int t0 = tile * 64, b = t0 >> 11, s0 = t0 & 2047, tid = F.tid;
    LAS float* invL = (LAS float*)F.lds;
    if (tid < 80) { const int s = s0 - 8 + tid; float inv = 0.f;
        if (s >= 0 && s < SEQ) { const GAS f32x4* sp = (const GAS f32x4*)(ssq + (size_t)(b * SEQ + s) * 16); const f32x4 a = sp[0], bq = sp[1], cq = sp[2], dq = sp[3];
            const float tot = ((a[0] + a[1]) + (a[2] + a[3])) + ((bq[0] + bq[1]) + (bq[2] + bq[3])) + ((cq[0] + cq[1]) + (cq[2] + cq[3])) + ((dq[0] + dq[1]) + (dq[2] + dq[3]));
            inv = 1.0f / sqrtf(tot * (1.0f / D) + RMS_EPS); }
        invL[tid] = inv; }
    __syncthreads();
    const int q = tid & 255, th = tid >> 8, c = 4 * q, gi = q >> 6, w = 2 << gi, half = w >> 1;
    const f32x4 g4 = *(const GAS f32x4*)(F.norm_mix_g + D + c);
    const float* xcol = F.out + (size_t)b * SEQ * D + c;
#define POOL_H(s) (((s) >= 0 && (s) < SEQ) ? (*(const GAS f32x4*)(xcol + (size_t)(s) * D)) * g4 * invL[(s) - s0 + 8] : (f32x4){0.f, 0.f, 0.f, 0.f})
    const int ts = s0 + th * 32;
    f32x4 S = (f32x4){0.f, 0.f, 0.f, 0.f};
    for (int s = ts - half; s < ts - half + w; ++s) S += POOL_H(s);
    for (int i = 0; i < 32; ++i) {
        const int t = ts + i; const int lo = (t - half) < 0 ? 0 : (t - half), hi = (t - half + w) > SEQ ? SEQ : (t - half + w);
        const float rc = 1.0f / (float)(hi - lo);
        const f32x4 h = POOL_H(t);
        const f32x4 pg = S * rc - h;
        u32x2 o; o.x = pk2(pg[0], pg[1]); o.y = pk2(pg[2], pg[3]);
        *(GAS u32x2*)(F.XBa + (size_t)(b * SEQ + t) * D + c) = o;
        S += POOL_H(t - half + w); S -= POOL_H(t - half);
    }
#undef POOL_H
    __syncthreads();
}

struct Args { const float* in[16]; float* out; unsigned char* ws; int ph_lo, ph_hi; };
__global__ void __launch_bounds__(NWAVES * 64, 2) fwd_mega(Args args) {
    extern __shared__ __attribute__((aligned(16))) unsigned char lds[];
    Frame F;
    F.lds = (LAS unsigned char*)lds;
    F.MISC = (volatile LAS unsigned*)(F.lds + MISC_OFF);
    F.tid = threadIdx.x; F.lane = F.tid & 63; F.wave = __builtin_amdgcn_readfirstlane(F.tid >> 6);
    F.G = gridDim.x; { const int bx = blockIdx.x; F.vcu = (F.G % 8 == 0) ? (bx % 8) * (F.G / 8) + bx / 8 : bx; }
    unsigned char* ws = args.ws;
    F.ctl = (gu32*)(ws + WS_CTL);
    F.x = args.in[0]; F.norm_mix_g = args.in[1]; F.norm_ffn_g = args.in[2]; F.w_in = args.in[3]; F.fnet_map = args.in[4]; F.conv_w = args.in[5]; F.conv_b = args.in[6];
    F.ln_g = args.in[7]; F.ln_b = args.in[8]; F.w_out = args.in[9]; F.pool_map = args.in[10]; F.pool_scale = args.in[11]; F.w_gate = args.in[12]; F.w_up = args.in[13]; F.w_down = args.in[14]; F.final_g = args.in[15];
    F.out = args.out; F.ssq = (float*)(ws + WS_SSQ);
    F.WinT = (bf16_t*)(ws + WS_WIN); F.WoT = (bf16_t*)(ws + WS_WO); F.WguT = (bf16_t*)(ws + WS_WGU); F.WdT = (bf16_t*)(ws + WS_WD); F.PmT = (bf16_t*)(ws + WS_PM); F.DM = (bf16_t*)(ws + WS_DM);
    F.XBa = (bf16_t*)(ws + WS_XBA); F.XBb = (bf16_t*)(ws + WS_XBB); F.AT = (bf16_t*)(ws + WS_AT); F.U = (bf16_t*)(ws + WS_U); F.YQ = (bf16_t*)(ws + WS_YQ); F.HID = (bf16_t*)(ws + WS_HID);
    for (int u = F.tid; u < (LDS_BYTES - LDSCTL_OFF) / 4; u += NWAVES * 64) ((LAS unsigned*)(F.lds + LDSCTL_OFF))[u] = 0u;
    __syncthreads();
    XcdBarrier bar; bar.bar = (unsigned*)(F.ctl + CW_BAR); bar.x = 0; bar.st = nullptr;
#if !MK_SPLIT
    bar = xcd_barrier_post((unsigned*)(F.ctl + CW_BAR), F.MISC + 8);
#endif
    const int lo = args.ph_lo, hi = args.ph_hi;
#define IN(k) (lo <= (k) && (k) < hi)
#if MK_SPLIT
#define SEAM(k) do { } while (0)
#else
#define SEAM(k) do { if (IN(k) && IN((k) + 1)) { if ((k) == 0) xcd_barrier<true>(bar); else xcd_barrier<false>(bar); } } while (0)
#endif
    const int bx = (int)blockIdx.x;

    if (IN(0)) { p0_prologue(F); }
    SEAM(0);
    if (IN(1)) {
        pg8::ProbIn p; p.init(64, 6, F.G, bx); p.K = 1024; p.lda = 1024; p.ldb = 1024; p.X = F.XBa; p.WinT = F.WinT; p.AT = F.AT; p.U = F.U;
        pg8::gemm_phase<pg8::ProbIn, true>(F.lds, p);
    }
    SEAM(1);
    if (IN(2)) {
        pg8::ProbDft p; p.init(16, 16, F.G, bx); p.K = 2048; p.lda = 2048; p.ldb = 2048; p.DM = F.DM; p.AT = F.AT; p.YQ = F.YQ;
        pg8::gemm_phase<pg8::ProbDft, true>(F.lds, p);
        for (int t = F.vcu; t < MTOK / 64; t += F.G) conv_tile(F, t);
    }
    SEAM(2);
    if (IN(3)) {
        pg8::ProbRes p; p.init(64, 4, F.G, bx); p.K = KOUT; p.lda = KOUT; p.ldb = KOUT; p.A = F.YQ; p.Bt = F.WoT; p.a_pm = (size_t)256 * KOUT; p.a_pn = 0; p.b_pn = (size_t)256 * KOUT;
        p.base = F.x; p.out = F.out; p.xb = F.XBb; p.scale = nullptr; p.ssq = F.ssq;
        pg8::gemm_phase<pg8::ProbRes, true>(F.lds, p);
    }
    SEAM(3);
#pragma unroll
    for (int l = 0; l < 2; ++l) {
        const int pb = 4 + 4 * l;
        if (IN(pb)) {
            pg8::ProbGlu p; p.init(64, 22, F.G, bx); p.K = 1024; p.lda = 1024; p.ldb = 1024; p.A = F.XBb; p.Bt = F.WguT + (size_t)l * 5632 * 1024; p.ssq = F.ssq + (size_t)(2 * l) * MTOK * 16; p.H = F.HID;
            pg8::gemm_phase<pg8::ProbGlu, true>(F.lds, p);
        }
        SEAM(pb);
        if (IN(pb + 1)) {
            pg8::ProbRes p; p.init(64, 4, F.G, bx); p.K = DFF; p.lda = DFF; p.ldb = DFF; p.A = F.HID; p.Bt = F.WdT + (size_t)l * 1024 * DFF; p.a_pm = (size_t)256 * DFF; p.a_pn = 0; p.b_pn = (size_t)256 * DFF;
            p.base = F.out; p.out = F.out; p.xb = nullptr; p.scale = nullptr; p.ssq = F.ssq + (size_t)(2 * l + 1) * MTOK * 16;
            pg8::gemm_phase<pg8::ProbRes, true>(F.lds, p);
        }
        SEAM(pb + 1);
        if (l == 0) {
            if (IN(6)) { for (int t = F.vcu; t < MTOK / 64; t += F.G) pool_tile(F, t, F.ssq + (size_t)1 * MTOK * 16); }
            SEAM(6);
            if (IN(7)) {
                pg8::ProbRes p; p.init(64, 4, F.G, bx); p.K = 256; p.lda = 1024; p.ldb = 256; p.A = F.XBa; p.Bt = F.PmT; p.a_pm = (size_t)256 * 1024; p.a_pn = 256; p.b_pn = (size_t)256 * 256;
                p.base = F.out; p.out = F.out; p.xb = F.XBb; p.scale = F.pool_scale; p.ssq = F.ssq + (size_t)2 * MTOK * 16;
                pg8::gemm_phase<pg8::ProbRes, true>(F.lds, p);
            }
            SEAM(7);
        }
    }
    if (IN(10)) {
        const float* ssq = F.ssq + (size_t)3 * MTOK * 16;
        const int gw = F.vcu * NWAVES + F.wave, NGW = F.G * NWAVES;
        for (int m = gw; m < MTOK; m += NGW) {
            GAS f32x4* xr = (GAS f32x4*)(F.out + (size_t)m * D) + F.lane;
            const GAS f32x4* gr = (const GAS f32x4*)(F.final_g) + F.lane;
            const float pv = (F.lane < 16) ? ssq[(size_t)m * 16 + F.lane] : 0.f;
            const float inv = 1.0f / sqrtf(wave_sum(pv) * (1.0f / D) + RMS_EPS);
#pragma unroll
            for (int j = 0; j < 4; ++j) { const f32x4 v = xr[64 * j], g = gr[64 * j]; xr[64 * j] = v * inv * g; }
        }
    }
#undef IN
#undef SEAM
}

extern "C" void kernel_launch(void* const* d_in, const int* in_sizes, int n_in, void* d_out, int out_size, void* d_ws, size_t ws_size, hipStream_t stream) {
    static int grid = 0;
    if (grid == 0) {
        if (n_in != 16 || in_sizes[0] != MTOK * D || out_size != MTOK * D || ws_size < WS_END) { fprintf(stderr, "kernel_launch: unexpected shapes (n_in %d, in0 %d, out %d, ws %zu)\n", n_in, n_in > 0 ? in_sizes[0] : -1, out_size, ws_size); grid = -1; return; }
        int dev = 0, cus = 0, per_cu = 0;
        if (hipGetDevice(&dev) != hipSuccess || hipDeviceGetAttribute(&cus, hipDeviceAttributeMultiprocessorCount, dev) != hipSuccess) { grid = -1; return; }
        if (hipFuncSetAttribute((const void*)fwd_mega, hipFuncAttributeMaxDynamicSharedMemorySize, LDS_BYTES) != hipSuccess) { fprintf(stderr, "kernel_launch: hipFuncSetAttribute failed\n"); grid = -1; return; }
        if (hipOccupancyMaxActiveBlocksPerMultiprocessor(&per_cu, (const void*)fwd_mega, NWAVES * 64, LDS_BYTES) != hipSuccess || per_cu < 1) { fprintf(stderr, "kernel_launch: occupancy query says %d blocks/CU\n", per_cu); per_cu = 1; }
        (void)hipGetLastError();
        grid = cus;
    }
    if (grid < 0) return;
    if (hipMemsetAsync((char*)d_ws + WS_CTL, 0, CTL_ZERO_BYTES, stream) != hipSuccess) { fprintf(stderr, "kernel_launch: memset failed\n"); return; }
    Args a{};
    for (int i = 0; i < 16; ++i) a.in[i] = (const float*)d_in[i];
    a.out = (float*)d_out; a.ws = (unsigned char*)d_ws;
#if MK_SPLIT
    for (int ph = 0; ph < N_PHASES; ++ph) { a.ph_lo = ph; a.ph_hi = ph + 1; hipLaunchKernelGGL(fwd_mega, dim3(grid), dim3(NWAVES * 64), LDS_BYTES, stream, a); }
#else
    a.ph_lo = 0; a.ph_hi = N_PHASES;
    hipLaunchKernelGGL(fwd_mega, dim3(grid), dim3(NWAVES * 64), LDS_BYTES, stream, a);
#endif
    const hipError_t le = hipPeekAtLastError();
    if (le != hipSuccess) fprintf(stderr, "kernel_launch: launch failed: %s\n", hipGetErrorName(le));
}
```

```cpp
#include <hip/hip_runtime.h>
#include <cstdio>
#include <cstdint>

#ifndef MK_SPLIT
#define MK_SPLIT 0
#endif

#ifndef PROBE_PH
#define PROBE_PH (-1)
#define PROBE_REP 0
#endif
#ifndef DIAG_PH
#define DIAG_PH (-1)
#define DIAG_SCALE 0.01f
#endif
#ifndef PROBE_EPI2
#define PROBE_EPI2 0
#endif
#ifndef PROBE_KMULT
#define PROBE_KMULT 1
#define PROBE_KMULT_PH (-1)
#endif
#ifndef PROBE_CONV_MULT
#define PROBE_CONV_MULT 1
#define PROBE_DFT_MULT 1
#endif
#define LAS __attribute__((address_space(3)))
#define GAS __attribute__((address_space(1)))
typedef unsigned short bf16_t;
typedef short bf16x8 __attribute__((ext_vector_type(8)));
typedef float f32x4 __attribute__((ext_vector_type(4)));
typedef float f32x2 __attribute__((ext_vector_type(2)));
typedef unsigned u32x4 __attribute__((ext_vector_type(4)));
typedef unsigned u32x2 __attribute__((ext_vector_type(2)));
typedef GAS unsigned gu32;

constexpr int BATCH = 8, SEQ = 2048, D = 1024, MTOK = BATCH * SEQ;
constexpr int INAB = 1536, DFF = 2816, KOUT = 1536;
constexpr float RMS_EPS = 1e-6f, LN_EPS = 1e-5f;
constexpr int NWAVES = 8;
constexpr int N_PHASES = 10;

constexpr size_t MiB = 1u << 20;
constexpr size_t WS_CTL = 0, CTL_ZERO_BYTES = 40960;
constexpr size_t WS_SSQ = 1 * MiB;
constexpr size_t WS_WIN = 5 * MiB;
constexpr size_t WS_WO = 8 * MiB;
constexpr size_t WS_WGU = 11 * MiB;
constexpr size_t WS_WD = 33 * MiB;
constexpr size_t WS_PM = 44 * MiB;
constexpr size_t WS_DM = 45 * MiB;
constexpr size_t WS_XBA = 61 * MiB;
constexpr size_t WS_XBB = 93 * MiB;
constexpr size_t WS_BB = 125 * MiB;
constexpr size_t BBS = 11 * MiB / 2;
constexpr size_t WS_AT = WS_BB;
constexpr size_t WS_U = WS_BB + 2 * MiB;
constexpr size_t WS_YQ = WS_BB + 4 * MiB;
constexpr size_t WS_HID = WS_BB;
constexpr size_t WS_END = 213 * MiB;
constexpr int CW_BAR = 4096;
constexpr int CW_XID = 8960;
constexpr int CW_GRP = 7680;

constexpr int RING_BYTES = 131072;
constexpr int LDSCTL_OFF = RING_BYTES, MISC_OFF = LDSCTL_OFF + 320;
constexpr int STASH_OFF = LDSCTL_OFF + 1024;
constexpr int INVTAB_OFF = STASH_OFF + 16384;
constexpr int LDS_BYTES = INVTAB_OFF + 1024;

#define LDS_WAIT() asm volatile("s_waitcnt lgkmcnt(0)" ::: "memory")
#define VM_WAIT() asm volatile("s_waitcnt vmcnt(0)" ::: "memory")
__device__ __forceinline__ unsigned f2bf(float f) { unsigned u = __builtin_bit_cast(unsigned, f); return (u + 0x7fffu + ((u >> 16) & 1u)) >> 16; }
__device__ __forceinline__ unsigned pk2(float lo, float hi) { return f2bf(lo) | (f2bf(hi) << 16); }
__device__ __forceinline__ unsigned cvt_pk_bf16(float lo, float hi) { unsigned r; asm volatile("v_cvt_pk_bf16_f32 %0, %1, %2" : "=v"(r) : "v"(lo), "v"(hi)); return r; }
__device__ __forceinline__ float bf_lo(unsigned w) { return __builtin_bit_cast(float, w << 16); }
__device__ __forceinline__ float bf_hi(unsigned w) { return __builtin_bit_cast(float, w & 0xffff0000u); }
__device__ __forceinline__ float wave_sum(float v) {
    v += __builtin_bit_cast(float, __builtin_amdgcn_update_dpp(0, __builtin_bit_cast(int, v), 0xB1, 0xf, 0xf, true));
    v += __builtin_bit_cast(float, __builtin_amdgcn_update_dpp(0, __builtin_bit_cast(int, v), 0x4E, 0xf, 0xf, true));
    v += __builtin_bit_cast(float, __builtin_amdgcn_update_dpp(0, __builtin_bit_cast(int, v), 0x141, 0xf, 0xf, true));
    v += __builtin_bit_cast(float, __builtin_amdgcn_update_dpp(0, __builtin_bit_cast(int, v), 0x140, 0xf, 0xf, true));
    { float a = v, b = v; asm("s_nop 1\n\tv_permlane16_swap_b32 %0, %1\n\ts_nop 1" : "+v"(a), "+v"(b)); v = a + b; }
    { float a = v, b = v; asm("s_nop 1\n\tv_permlane32_swap_b32 %0, %1\n\ts_nop 1" : "+v"(a), "+v"(b)); v = a + b; }
    return v;
}
__device__ __forceinline__ float fast_sigmoid(float g) { return __builtin_amdgcn_rcpf(1.0f + __builtin_amdgcn_exp2f(g * -1.44269504089f)); }

#define XB_TMO      128
#define XB_XCNT(j)  (256  + 64 * (j))
#define XB_XSUB(j)  (1280 + 64 * (j))
#define XB_XGEN(j)  (2304 + 64 * (j))
#define XB_TOP      3328
#define XB_TOPGEN   3392
#define XCD_BAR_WORDS 3456
#define XB_SPIN_CAP (1u << 18)
__device__ __forceinline__ unsigned xb_ld(unsigned* p)              { return __hip_atomic_load(p, __ATOMIC_RELAXED, __HIP_MEMORY_SCOPE_AGENT); }
__device__ __forceinline__ unsigned xb_add(unsigned* p, unsigned v) { return __hip_atomic_fetch_add(p, v, __ATOMIC_RELAXED, __HIP_MEMORY_SCOPE_AGENT); }
__device__ __forceinline__ unsigned xb_xcc_id() { return (unsigned)__builtin_amdgcn_s_getreg((3 << 11) | 20) & 0xFu; }
#define XB_SPIN(cond, bar) do { unsigned _sp = 0; while (cond) { __builtin_amdgcn_s_sleep(1); \
    if ((++_sp & 255u) == 0u) { if (xb_ld(&(bar)[XB_TMO])) break; if (_sp > XB_SPIN_CAP) { atomicAdd(&(bar)[XB_TMO], 1u); break; } } } } while (0)
struct XcdBarrier { unsigned* bar; unsigned x; volatile LAS unsigned* st; };
__device__ __forceinline__ XcdBarrier xcd_barrier_post(unsigned* bar, volatile LAS unsigned* st) {
    XcdBarrier b; b.bar = bar; b.x = xb_xcc_id(); b.st = st;
    if (threadIdx.x == 0) (void)xb_add(&bar[XB_XCNT(b.x)], 1u);
    return b;
}
__device__ __forceinline__ void xcd_barrier_complete(unsigned* bar, unsigned x, unsigned& nloc, unsigned& nx) {
    const unsigned G = gridDim.x * gridDim.y * gridDim.z;
    unsigned sum, cnt, mine, sp = 0u;
    for (;;) {
        sum = 0u; cnt = 0u; mine = 0u;
#pragma unroll
        for (unsigned j = 0; j < 16; ++j) { const unsigned c = xb_ld(&bar[XB_XCNT(j)]); sum += c; cnt += (c > 0u) ? 1u : 0u; mine = (j == x) ? c : mine; }
        if (sum == G) break;
        __builtin_amdgcn_s_sleep(1);
        if ((++sp & 255u) == 0u) { if (xb_ld(&bar[XB_TMO])) break; if (sp > XB_SPIN_CAP) { atomicAdd(&bar[XB_TMO], 1u); break; } }
    }
    nloc = mine > 0u ? mine : 1u; nx = cnt > 0u ? cnt : 1u;
}
template <bool FIRST>
__device__ __forceinline__ void xcd_barrier(const XcdBarrier& b) {
    asm volatile("s_waitcnt vmcnt(0)" ::: "memory");
    __syncthreads();
    if (threadIdx.x == 0) {
        unsigned* bar = b.bar;
        __builtin_amdgcn_s_waitcnt(0);
        unsigned nloc = b.st[0], nx = b.st[1];
        if (FIRST) { xcd_barrier_complete(bar, b.x, nloc, nx); b.st[0] = nloc; b.st[1] = nx; }
        const unsigned old = xb_add(&bar[XB_XSUB(b.x)], 1u);
        const unsigned gen = old / nloc;
        if (old + 1u == (gen + 1u) * nloc) {
            __builtin_amdgcn_fence(__ATOMIC_RELEASE, "agent");
            asm volatile("s_waitcnt vmcnt(0)" ::: "memory");
            const unsigned og = xb_add(&bar[XB_TOP], 1u);
            const unsigned tg = og / nx;
            if (og + 1u == (tg + 1u) * nx) xb_add(&bar[XB_TOPGEN], 1u);
            else XB_SPIN(xb_ld(&bar[XB_TOPGEN]) == tg, bar);
            __builtin_amdgcn_fence(__ATOMIC_ACQUIRE, "agent");
            xb_add(&bar[XB_XGEN(b.x)], 1u);
            asm volatile("s_waitcnt vmcnt(0)" ::: "memory");
        } else {
            XB_SPIN(xb_ld(&bar[XB_XGEN(b.x)]) == gen, bar);
            __builtin_amdgcn_fence(__ATOMIC_ACQUIRE, "agent");
            asm volatile("s_waitcnt vmcnt(0)" ::: "memory");
        }
    }
    __syncthreads();
}

__device__ __forceinline__ void grp_barrier(unsigned* ctl, unsigned g, unsigned n, volatile LAS unsigned* coloc) {
    asm volatile("s_waitcnt vmcnt(0)" ::: "memory");
    __syncthreads();
    if (threadIdx.x == 0) {
        unsigned* cnt = ctl + CW_GRP + 64 * g; unsigned* gen = ctl + CW_GRP + 64 * (8 + g);
        __builtin_amdgcn_s_waitcnt(0);
        if (coloc[0] == 0u) {
            __builtin_amdgcn_fence(__ATOMIC_RELEASE, "agent");
            asm volatile("s_waitcnt vmcnt(0)" ::: "memory"); }
        const unsigned old = xb_add(cnt, 1u), ge = old / n;
        if (old + 1u == (ge + 1u) * n) xb_add(gen, 1u);
        else { unsigned sp = 0; while (xb_ld(gen) == ge) { __builtin_amdgcn_s_sleep(1); if (++sp > (1u << 20)) break; } }
        __builtin_amdgcn_fence(__ATOMIC_ACQUIRE, "agent");
        asm volatile("s_waitcnt vmcnt(0)" ::: "memory");
    }
    __syncthreads();
}

namespace pg8 {
constexpr int BM = 256, BK = 64, HALF = 128, HTB = HALF * BK * 2, STAGE_BYTES = 8 * HTB, NXCD = 8, WGM = 8;
__host__ __device__ __forceinline__ int lds_byte(int r, int c) { const int st = (r >> 4) * 2 + (c >> 5), rr = r & 15, cc = c & 31, ob = rr * 64 + cc * 2; return st * 1024 + (ob ^ (((ob >> 9) & 1) << 5)); }
__host__ __device__ __forceinline__ void stage_rc(int b, int& R, int& C) { const int st = b / 1024, sb = b % 1024, swz = sb ^ (((sb >> 9) & 1) << 5); R = (st >> 1) * 16 + swz / 64; C = (st & 1) * 32 + (swz % 64) / 2; }
__host__ __device__ __forceinline__ int perm32(int rho) { const int n = rho >> 4, i = rho & 15; return 8 * (i >> 2) + 4 * n + (i & 3); }
struct Unit { int pm, pn; };
struct Order {
    int nM, nN, nwg, G, c, mult = 1, kmult = 1; bool epi2 = false;
    __device__ __forceinline__ void init(int nM_, int nN_, int G_, int c_) { nM = nM_; nN = nN_; nwg = nM * nN; G = G_; c = c_; }
    __device__ __forceinline__ bool next(int i, Unit& u) const {
        const long L = (long)i * G + c; if (L >= (long)nwg * mult) return false;
        if (nM == 64 && (G & 7) == 0 && mult == 1) {
            const int w = (int)L >> 3; u.pm = 8 * ((int)L & 7) + (w & 7); u.pn = w >> 3; return true; }
        int wgid = (int)(L % nwg); { const int q = nwg / NXCD, r = nwg % NXCD, xcd = wgid % NXCD, off = wgid / NXCD; wgid = (xcd < r ? xcd * (q + 1) : r * (q + 1) + (xcd - r) * q) + off; }
        const int nig = WGM * nN, gid = wgid / nig, fm = gid * WGM, gsz = (nM - fm) < WGM ? (nM - fm) : WGM;
        u.pm = fm + ((wgid % nig) % gsz); u.pn = (wgid % nig) / gsz; return true;
    }
};
template <class P, bool ALIGN_EPI, bool HM = false>
__device__ __forceinline__ void gemm_phase(LAS unsigned char* lds, const P& p) {
    int tid = threadIdx.x; asm volatile("" : "+v"(tid));
    const int wid = __builtin_amdgcn_readfirstlane(tid >> 6), lane = tid & 63, wr = wid >> 2, wc = wid & 3, fr = lane & 15, fq = lane >> 4;
    const int K = p.K, nt = K / BK;
    unsigned voffA[2], voffB[2];
#pragma unroll
    for (int i = 0; i < 2; ++i) { int R, C; stage_rc(tid * 16 + i * 8192, R, C); const int Rb = P::PERM ? ((R & ~31) + perm32(R & 31)) : R;
        voffA[i] = (unsigned)(R * p.lda + C) * 2u; voffB[i] = (unsigned)(Rb * p.ldb + C) * 2u; }
    const size_t kstep = (size_t)(BK * 2);
    const size_t hstepA = (size_t)HALF * p.lda * 2, hstepB = (size_t)HALF * p.ldb * 2;
    const unsigned ldsw = (unsigned)wid * 1024u;
    const int aoff = lds_byte(wr * 64 + fr, fq * 8), boff = lds_byte(wc * 32 + fr, fq * 8);
#define PG8_SA(b, h) (((b) * 2 + (h)) * HTB)
#define PG8_SB(b, h) ((4 + (b) * 2 + (h)) * HTB)
#define PG8_STAGE(bufoff, gbase, voff) do { _Pragma("unroll") for (int _i = 0; _i < 2; ++_i) \
        __builtin_amdgcn_global_load_lds((const unsigned*)((const char*)(gbase) + (voff)[_i]), (LAS unsigned*)(lds + (bufoff) + ldsw + _i * 8192), 16, 0, 0); } while (0)
#define PG8_LDA(dst, b, h) do { _Pragma("unroll") for (int m = 0; m < 4; ++m) _Pragma("unroll") for (int k = 0; k < 2; ++k) dst[m][k] = *(const LAS bf16x8*)(lds + PG8_SA(b, h) + aoff + m * 2048 + k * 1024); } while (0)
#define PG8_LDB(dst, b, h) do { _Pragma("unroll") for (int n = 0; n < 2; ++n) _Pragma("unroll") for (int k = 0; k < 2; ++k) dst[n][k] = *(const LAS bf16x8*)(lds + PG8_SB(b, h) + boff + n * 2048 + k * 1024); } while (0)
#define PG8_MMA(ai, bj, At, Bt) do { __builtin_amdgcn_s_setprio(1); _Pragma("unroll") for (int m = 0; m < 4; ++m) _Pragma("unroll") for (int n = 0; n < 2; ++n) _Pragma("unroll") for (int k = 0; k < 2; ++k) \
        acc[ai][bj][m][n] = __builtin_amdgcn_mfma_f32_16x16x32_bf16(Bt[n][k], At[m][k], acc[ai][bj][m][n], 0, 0, 0); __builtin_amdgcn_s_setprio(0); } while (0)
#define PG8_WAIT_V(n) asm volatile("s_waitcnt vmcnt(" #n ")" ::: "memory")
#define PG8_WAIT_L(n) asm volatile("s_waitcnt lgkmcnt(" #n ")" ::: "memory")
#define PG8_BAR __builtin_amdgcn_s_barrier()
#define PG8_SCHED __builtin_amdgcn_sched_barrier(0)
    Unit cur, nxt; int ui = 0;
    if (!p.next(0, cur)) return;
    f32x4 acc[2][2][4][2];
#pragma unroll
    for (int a = 0; a < 2; ++a)
#pragma unroll
        for (int b = 0; b < 2; ++b)
#pragma unroll
            for (int m = 0; m < 4; ++m)
#pragma unroll
                for (int n = 0; n < 2; ++n) acc[a][b][m][n] = (f32x4){0.f, 0.f, 0.f, 0.f};
    bf16x8 At[4][2], B0[2][2], B1[2][2];
    const char* cA = p.aptr(cur); const char* cB = p.bptr(cur);
    PG8_STAGE(PG8_SB(0, 0), cB, voffB); PG8_STAGE(PG8_SB(0, 1), cB + hstepB, voffB); PG8_STAGE(PG8_SA(0, 0), cA, voffA); if constexpr (!HM) PG8_STAGE(PG8_SA(0, 1), cA + hstepA, voffA);
    if (wr == 1) PG8_BAR;
    if constexpr (HM) PG8_WAIT_V(0); else PG8_WAIT_V(2);
    PG8_BAR;
    PG8_STAGE(PG8_SB(1, 0), cB + kstep, voffB); PG8_STAGE(PG8_SA(1, 0), cA + kstep, voffA); PG8_STAGE(PG8_SB(1, 1), cB + hstepB + kstep, voffB);
    PG8_WAIT_V(6); PG8_BAR;
    for (;;) {
        const bool has_next = p.next(ui + 1, nxt);
        const char* nA = has_next ? p.aptr(nxt) : cA; const char* nB = has_next ? p.bptr(nxt) : cB;
#if PROBE_KMULT > 1
        for (int tt = 0; tt < nt * p.kmult; tt += 2) {
            const int t = tt % nt; const bool last = (tt == nt * p.kmult - 2);
            const char* a1 = cA + (size_t)(t + 1) * kstep;
            const char* a2 = last ? nA : cA + (size_t)((t + 2) % nt) * kstep; const char* b2 = last ? nB : cB + (size_t)((t + 2) % nt) * kstep;
#else
        for (int t = 0; t < nt; t += 2) {
            const bool last = (t == nt - 2);
            const char* a1 = cA + (size_t)(t + 1) * kstep;
            const char* a2 = last ? nA : cA + (size_t)(t + 2) * kstep; const char* b2 = last ? nB : cB + (size_t)(t + 2) * kstep;
#endif
            const char* a3 = a2 + kstep; const char* b3 = b2 + kstep;
            if constexpr (P::HAS_PRE) { if (last) p.pre(cur, lds, wid, lane); }
            PG8_LDB(B0, 0, 0); PG8_LDB(B1, 0, 1); PG8_SCHED; PG8_LDA(At, 0, 0); if constexpr (!HM) PG8_STAGE(PG8_SA(1, 1), a1 + hstepA, voffA);
            PG8_WAIT_V(8); PG8_WAIT_L(0); PG8_BAR; PG8_MMA(0, 0, At, B0); PG8_MMA(0, 1, At, B1); PG8_BAR; PG8_SCHED;
            if constexpr (!HM) PG8_LDA(At, 0, 1);
            PG8_STAGE(PG8_SB(0, 0), b2, voffB); PG8_STAGE(PG8_SB(0, 1), b2 + hstepB, voffB); PG8_STAGE(PG8_SA(0, 0), a2, voffA);
            if constexpr (HM) PG8_WAIT_V(6); else PG8_WAIT_V(8);
            PG8_WAIT_L(0); PG8_BAR; if constexpr (!HM) { PG8_MMA(1, 0, At, B0); PG8_MMA(1, 1, At, B1); } PG8_BAR; PG8_SCHED;
            PG8_LDB(B0, 1, 0); PG8_LDB(B1, 1, 1); PG8_SCHED; PG8_LDA(At, 1, 0); if constexpr (!HM) PG8_STAGE(PG8_SA(0, 1), a2 + hstepA, voffA);
            PG8_WAIT_V(8); PG8_WAIT_L(0); PG8_BAR; PG8_MMA(0, 0, At, B0); PG8_MMA(0, 1, At, B1); PG8_BAR; PG8_SCHED;
            if constexpr (!HM) PG8_LDA(At, 1, 1);
            PG8_STAGE(PG8_SB(1, 0), b3, voffB); PG8_STAGE(PG8_SB(1, 1), b3 + hstepB, voffB); PG8_STAGE(PG8_SA(1, 0), a3, voffA);
            if constexpr (HM) PG8_WAIT_V(6); else PG8_WAIT_V(8);
            PG8_WAIT_L(0); PG8_BAR; if constexpr (!HM) { PG8_MMA(1, 0, At, B0); PG8_MMA(1, 1, At, B1); } PG8_BAR; PG8_SCHED;
        }
        if constexpr (ALIGN_EPI) { if (wr == 0) PG8_BAR; }
#if PROBE_KMULT > 1
        if (p.kmult > 1) { const float sc_ = 1.0f / (float)p.kmult;
#pragma unroll
            for (int a = 0; a < 2; ++a)
#pragma unroll
                for (int b = 0; b < 2; ++b)
#pragma unroll
                    for (int m = 0; m < 4; ++m)
#pragma unroll
                        for (int n = 0; n < 2; ++n) acc[a][b][m][n] *= sc_; }
#endif
        p.epi(acc, cur, wr, wc, fr, fq, lds);
        if (PROBE_EPI2 && p.epi2) { asm volatile("" ::: "memory"); p.epi(acc, cur, wr, wc, fr, fq, lds); }
        if (!has_next) break;
#pragma unroll
        for (int a = 0; a < 2; ++a)
#pragma unroll
            for (int b = 0; b < 2; ++b)
#pragma unroll
                for (int m = 0; m < 4; ++m)
#pragma unroll
                    for (int n = 0; n < 2; ++n) acc[a][b][m][n] = (f32x4){0.f, 0.f, 0.f, 0.f};
        cur = nxt; cA = nA; cB = nB; ++ui;
        if constexpr (ALIGN_EPI) { if (wr == 1) PG8_BAR; }
    }
    PG8_WAIT_V(0);
    if constexpr (!ALIGN_EPI) { if (wr == 0) PG8_BAR; }
    PG8_BAR;
#undef PG8_SA
#undef PG8_SB
#undef PG8_STAGE
#undef PG8_LDA
#undef PG8_LDB
#undef PG8_MMA
#undef PG8_WAIT_V
#undef PG8_WAIT_L
#undef PG8_BAR
#undef PG8_SCHED
}

__device__ __forceinline__ u32x4 pack8(const f32x4 v0, const f32x4 v1) {
    u32x4 w; w.x = cvt_pk_bf16(v0[0], v0[1]); w.y = cvt_pk_bf16(v0[2], v0[3]); w.z = cvt_pk_bf16(v1[0], v1[1]); w.w = cvt_pk_bf16(v1[2], v1[3]); return w;
}

struct ProbIn : Order {
    static constexpr bool PERM = true, HAS_PRE = false;
    int K, lda, ldb;
    const bf16_t* X; const bf16_t* XF; const bf16_t* WinT; bf16_t* AT; bf16_t* U;
    __device__ __forceinline__ const char* aptr(const Unit& u) const { return u.pn >= 4 ? (const char*)(WinT + (size_t)(u.pn - 4) * 256 * 1024) : (const char*)(X + (size_t)u.pm * 256 * 1024); }
    __device__ __forceinline__ const char* bptr(const Unit& u) const { return u.pn >= 4 ? (const char*)(XF + (size_t)u.pm * 256 * 1024) : (const char*)(WinT + (size_t)(512 + u.pn * 256) * 1024); }
    __device__ __forceinline__ void epi(const f32x4 (&acc)[2][2][4][2], const Unit& u, int wr, int wc, int fr, int fq, LAS unsigned char* lds) const {
        if (u.pn >= 4) {
            const int tokc = u.pm * 256 + wc * 32 + 8 * fq;
#pragma unroll
            for (int ai = 0; ai < 2; ++ai)
#pragma unroll
                for (int m = 0; m < 4; ++m) { const int np = (u.pn - 4) * 256 + ai * 128 + wr * 64 + m * 16 + fr;
#pragma unroll
                    for (int bj = 0; bj < 2; ++bj) { const int tok = tokc + bj * 128, bcs = tok >> 10, s = tok & 1023;
                        *(u32x4*)(AT + (size_t)(bcs >> 1) * BBS + ((size_t)((bcs & 1) * 512 + np) * 1024 + s)) = pack8(acc[ai][bj][m][0], acc[ai][bj][m][1]); } }
        } else {
            const int ch0 = u.pn * 128 + wc * 32 + 8 * fq;
#pragma unroll
            for (int ai = 0; ai < 2; ++ai)
#pragma unroll
                for (int m = 0; m < 4; ++m) { const int row = u.pm * 256 + ai * 128 + wr * 64 + m * 16 + fr;
                    f32x4 o0, o1;
#pragma unroll
                    for (int j = 0; j < 4; ++j) { o0[j] = acc[ai][0][m][0][j] * fast_sigmoid(acc[ai][1][m][0][j]); o1[j] = acc[ai][0][m][1][j] * fast_sigmoid(acc[ai][1][m][1][j]); }
                    *(u32x4*)(U + (size_t)(row >> 11) * BBS + (size_t)(row & 2047) * 512 + ch0) = pack8(o0, o1); }
        }
    }
};
struct ProbDft : Order {
    static constexpr bool PERM = true, HAS_PRE = false;
    int K, lda, ldb;
    const bf16_t* DM; const bf16_t* AT; bf16_t* YQ; bool loc; int lg, lj;
    __device__ __forceinline__ bool next(int i, Unit& u) const { if (!loc) return Order::next(i, u); if (i > 0) return false; u.pm = lj & 15; u.pn = 2 * lg + (lj >> 4); return true; }
    __device__ __forceinline__ const char* aptr(const Unit& u) const { return (const char*)(DM + (size_t)u.pm * 256 * 1024); }
    __device__ __forceinline__ const char* bptr(const Unit& u) const { return (const char*)(AT + (size_t)(u.pn >> 1) * BBS + (size_t)((u.pm >> 3) * 512 + (u.pn & 1) * 256) * 1024); }
    __device__ __forceinline__ void epi(const f32x4 (&acc)[2][2][4][2], const Unit& u, int wr, int wc, int fr, int fq, LAS unsigned char* lds) const {
        const int cs = u.pm >> 3, b = u.pn >> 1, n0 = (u.pn & 1) * 256 + wc * 32 + 8 * fq;
        f32x4 e0[2], e1[2];
#pragma unroll
        for (int bj = 0; bj < 2; ++bj) { e0[bj] = (f32x4){0.f, 0.f, 0.f, 0.f}; e1[bj] = e0[bj]; }
        if (cs == 0) {
            const float sg = (fr & 1) ? -1.0f : 1.0f;
#pragma unroll
            for (int bj = 0; bj < 2; ++bj) { const bf16_t* ap = AT + (size_t)b * BBS + (size_t)(512 + n0 + bj * 128) * 1024;
#pragma unroll
                for (int j = 0; j < 4; ++j) { e0[bj][j] = sg * bf_lo((unsigned)ap[(size_t)j * 1024]); e1[bj][j] = sg * bf_lo((unsigned)ap[(size_t)(4 + j) * 1024]); } }
        }
#pragma unroll
        for (int ai = 0; ai < 2; ++ai)
#pragma unroll
            for (int m = 0; m < 4; ++m) { const int k = (u.pm & 7) * 256 + ai * 128 + wr * 64 + m * 16 + fr;
                bf16_t* rowp = YQ + (size_t)b * BBS + (size_t)k * KOUT + cs * 512 + n0;
#pragma unroll
                for (int bj = 0; bj < 2; ++bj) *(u32x4*)(rowp + bj * 128) = pack8(acc[ai][bj][m][0] + e0[bj], acc[ai][bj][m][1] + e1[bj]); }
    }
};
template <bool SCALE, bool BASEBF, bool OUTBF>
struct ProbRes : Order {
    static constexpr bool PERM = true, HAS_PRE = false;
    int K, lda, ldb;
    const bf16_t* A; const bf16_t* Bt; size_t a_bs, a_pm, a_pn, b_pn;
    const void* base; void* out; const float* scale; float* ssq;
    __device__ __forceinline__ const char* aptr(const Unit& u) const { return (const char*)(A + (size_t)(u.pm >> 3) * a_bs + (size_t)(u.pm & 7) * a_pm + (size_t)u.pn * a_pn); }
    __device__ __forceinline__ const char* bptr(const Unit& u) const { return (const char*)(Bt + (size_t)u.pn * b_pn); }
    __device__ __forceinline__ void epi(const f32x4 (&acc)[2][2][4][2], const Unit& u, int wr, int wc, int fr, int fq, LAS unsigned char* lds) const {
        const __amdgpu_buffer_rsrc_t rB = __builtin_amdgcn_make_buffer_rsrc((void*)base, 0, MTOK * D * (BASEBF ? 2 : 4), 0x00020000);
        const __amdgpu_buffer_rsrc_t rO = __builtin_amdgcn_make_buffer_rsrc((void*)out, 0, MTOK * D * (OUTBF ? 2 : 4), 0x00020000);
        const __amdgpu_buffer_rsrc_t rS = __builtin_amdgcn_make_buffer_rsrc((void*)ssq, 0, MTOK * 16 * 4, 0x00020000);
        const int vo = ((wr * 64 + fr) * D + wc * 32 + 8 * fq) * 4;
        const int vs = (wr * 64 + fr) * 64 + wc * 4;
        const int so0 = (u.pm * 256 * D + u.pn * 256) * 4;
        f32x4 sc[2][2];
        if (SCALE) {
            const int col0 = u.pn * 256 + wc * 32 + 8 * fq;
#pragma unroll
            for (int bj = 0; bj < 2; ++bj)
#pragma unroll
                for (int n = 0; n < 2; ++n) sc[bj][n] = *(const f32x4*)(scale + col0 + bj * 128 + 4 * n);
        }
        constexpr int DEP = BASEBF ? 2 : 3, NB = DEP + 1;
        f32x4 bv[NB][2][2]; u32x4 bh[NB][2];
#define RES_SO(s, bj) (so0 + ((((s) >> 2) * 128 + ((s) & 3) * 16) * D + (bj) * 128) * 4)
#define RES_LOAD(s) do { _Pragma("unroll") for (int bj = 0; bj < 2; ++bj) { \
            if (BASEBF) bh[(s) % NB][bj] = __builtin_amdgcn_raw_buffer_load_b128(rB, vo >> 1, RES_SO(s, bj) >> 1, 0); \
            else { bv[(s) % NB][bj][0] = __builtin_bit_cast(f32x4, __builtin_amdgcn_raw_buffer_load_b128(rB, vo, RES_SO(s, bj), 0)); \
                   bv[(s) % NB][bj][1] = __builtin_bit_cast(f32x4, __builtin_amdgcn_raw_buffer_load_b128(rB, vo + 16, RES_SO(s, bj), 0)); } } } while (0)
#pragma unroll
        for (int s = 0; s < DEP; ++s) RES_LOAD(s);
#pragma unroll
        for (int s = 0; s < 8; ++s) {
            if (s + DEP < 8) RES_LOAD(s + DEP);
            asm volatile("" ::: "memory");
            const int ai = s >> 2, m = s & 3;
            float sq = 0.f;
#pragma unroll
            for (int bj = 0; bj < 2; ++bj) {
                f32x4 b0, b1;
                if (BASEBF) { const u32x4 h = bh[s % NB][bj]; b0 = (f32x4){bf_lo(h.x), bf_hi(h.x), bf_lo(h.y), bf_hi(h.y)}; b1 = (f32x4){bf_lo(h.z), bf_hi(h.z), bf_lo(h.w), bf_hi(h.w)}; }
                else { b0 = bv[s % NB][bj][0]; b1 = bv[s % NB][bj][1]; }
                f32x4 o0, o1;
                if (SCALE) { o0 = b0 + acc[ai][bj][m][0] * sc[bj][0]; o1 = b1 + acc[ai][bj][m][1] * sc[bj][1]; }
                else { o0 = b0 + acc[ai][bj][m][0]; o1 = b1 + acc[ai][bj][m][1]; }
                if (OUTBF) *(u32x4*)((bf16_t*)out + (size_t)(u.pm * 256 + ai * 128 + wr * 64 + m * 16 + fr) * D + u.pn * 256 + bj * 128 + wc * 32 + 8 * fq) = pack8(o0, o1);
                else { __builtin_amdgcn_raw_buffer_store_b128(__builtin_bit_cast(u32x4, o0), rO, vo, RES_SO(s, bj), 0);
                       __builtin_amdgcn_raw_buffer_store_b128(__builtin_bit_cast(u32x4, o1), rO, vo + 16, RES_SO(s, bj), 0); }
                sq += (o0[0] * o0[0] + o0[1] * o0[1]) + (o0[2] * o0[2] + o0[3] * o0[3]) + (o1[0] * o1[0] + o1[1] * o1[1]) + (o1[2] * o1[2] + o1[3] * o1[3]);
            }
            sq += __shfl_xor(sq, 16); sq += __shfl_xor(sq, 32);
            if (fq == 0) __builtin_amdgcn_raw_buffer_store_b32(__builtin_bit_cast(unsigned, sq), rS, vs, (u.pm * 256 + ai * 128 + m * 16) * 64 + u.pn * 16, 0);
            asm volatile("" ::: "memory");
        }
#undef RES_LOAD
#undef RES_SO
    }
};
struct ProbGlu : Order {
    static constexpr bool PERM = true, HAS_PRE = true;
    int K, lda, ldb;
    const bf16_t* A; const bf16_t* Bt; const float* ssq; bf16_t* H;
    __device__ __forceinline__ const char* aptr(const Unit& u) const { return (const char*)(A + (size_t)u.pm * 256 * 1024); }
    __device__ __forceinline__ const char* bptr(const Unit& u) const { return (const char*)(Bt + (size_t)u.pn * 256 * 1024); }
    __device__ __forceinline__ void pre(const Unit& u, LAS unsigned char* lds, int wid, int lane) const {
        const char* src = (const char*)(ssq + (size_t)u.pm * 256 * 16) + wid * 2048 + lane * 16;
#pragma unroll
        for (int i = 0; i < 2; ++i) __builtin_amdgcn_global_load_lds((const unsigned*)(src + i * 1024), (LAS unsigned*)(lds + STASH_OFF + wid * 2048 + i * 1024), 16, 0, 0);
    }
    __device__ __forceinline__ void epi(const f32x4 (&acc)[2][2][4][2], const Unit& u, int wr, int wc, int fr, int fq, LAS unsigned char* lds) const {
        const int ch0 = u.pn * 128 + wc * 32 + 8 * fq;
        { const int t = threadIdx.x;
          if (t < 256) { const LAS f32x4* sp = (const LAS f32x4*)(lds + STASH_OFF + t * 64);
              const f32x4 s0 = sp[0], s1 = sp[1], s2 = sp[2], s3 = sp[3];
              const float tot = ((s0[0] + s0[1]) + (s0[2] + s0[3])) + ((s1[0] + s1[1]) + (s1[2] + s1[3])) + ((s2[0] + s2[1]) + (s2[2] + s2[3])) + ((s3[0] + s3[1]) + (s3[2] + s3[3]));
              ((LAS float*)(lds + INVTAB_OFF))[t] = 1.0f / sqrtf(tot * (1.0f / D) + RMS_EPS); }
          asm volatile("s_waitcnt lgkmcnt(0)" ::: "memory"); __builtin_amdgcn_s_barrier(); asm volatile("" ::: "memory"); }
        float inv[2][4];
#pragma unroll
        for (int ai = 0; ai < 2; ++ai)
#pragma unroll
            for (int m = 0; m < 4; ++m) inv[ai][m] = ((const LAS float*)(lds + INVTAB_OFF))[ai * 128 + wr * 64 + m * 16 + fr];
#pragma unroll
        for (int ai = 0; ai < 2; ++ai)
#pragma unroll
            for (int m = 0; m < 4; ++m) { const int row = u.pm * 256 + ai * 128 + wr * 64 + m * 16 + fr; const float iv = inv[ai][m];
                const float c1 = iv * -1.44269504089f, iv2 = iv * iv;
                f32x4 o[2];
#pragma unroll
                for (int n = 0; n < 2; ++n) { const f32x4 g = acc[ai][0][m][n], up = acc[ai][1][m][n]; const f32x4 t = g * c1, gu = g * up;
                    f32x4 e; e[0] = __builtin_amdgcn_exp2f(t[0]); e[1] = __builtin_amdgcn_exp2f(t[1]); e[2] = __builtin_amdgcn_exp2f(t[2]); e[3] = __builtin_amdgcn_exp2f(t[3]);
                    const f32x4 d = e + 1.0f;
                    f32x4 r; r[0] = __builtin_amdgcn_rcpf(d[0]); r[1] = __builtin_amdgcn_rcpf(d[1]); r[2] = __builtin_amdgcn_rcpf(d[2]); r[3] = __builtin_amdgcn_rcpf(d[3]);
                    o[n] = gu * (r * iv2); }
                *(u32x4*)(H + (size_t)(row >> 11) * BBS + (size_t)(row & 2047) * DFF + ch0) = pack8(o[0], o[1]); }
    }
};
struct ProbGluH : ProbGlu {
    __device__ __forceinline__ bool next(int i, Unit& u) const {
        if (i != 0) return false;
        const int L = 1280 + (c & 127), w = L >> 3; u.pm = 8 * (L & 7) + (w & 7); u.pn = w >> 3; return true;
    }
    __device__ __forceinline__ const char* aptr(const Unit& u) const { return (const char*)(A + ((size_t)u.pm * 256 + (size_t)(c >> 7) * 128) * 1024); }
    __device__ __forceinline__ void epi(const f32x4 (&acc)[2][2][4][2], const Unit& u, int wr, int wc, int fr, int fq, LAS unsigned char* lds) const {
        const int ch0 = u.pn * 128 + wc * 32 + 8 * fq, hf = c >> 7;
        { const int t = threadIdx.x;
          if (t < 256) { const LAS f32x4* sp = (const LAS f32x4*)(lds + STASH_OFF + t * 64);
              const f32x4 s0 = sp[0], s1 = sp[1], s2 = sp[2], s3 = sp[3];
              const float tot = ((s0[0] + s0[1]) + (s0[2] + s0[3])) + ((s1[0] + s1[1]) + (s1[2] + s1[3])) + ((s2[0] + s2[1]) + (s2[2] + s2[3])) + ((s3[0] + s3[1]) + (s3[2] + s3[3]));
              ((LAS float*)(lds + INVTAB_OFF))[t] = 1.0f / sqrtf(tot * (1.0f / D) + RMS_EPS); }
          asm volatile("s_waitcnt lgkmcnt(0)" ::: "memory"); __builtin_amdgcn_s_barrier(); asm volatile("" ::: "memory"); }
        float inv[4];
#pragma unroll
        for (int m = 0; m < 4; ++m) inv[m] = ((const LAS float*)(lds + INVTAB_OFF))[hf * 128 + wr * 64 + m * 16 + fr];
#pragma unroll
        for (int m = 0; m < 4; ++m) { const int row = u.pm * 256 + hf * 128 + wr * 64 + m * 16 + fr; const float iv = inv[m];
            const float c1 = iv * -1.44269504089f, iv2 = iv * iv;
            f32x4 o[2];
#pragma unroll
            for (int n = 0; n < 2; ++n) { const f32x4 g = acc[0][0][m][n], up = acc[0][1][m][n]; const f32x4 t = g * c1, gu = g * up;
                f32x4 e; e[0] = __builtin_amdgcn_exp2f(t[0]); e[1] = __builtin_amdgcn_exp2f(t[1]); e[2] = __builtin_amdgcn_exp2f(t[2]); e[3] = __builtin_amdgcn_exp2f(t[3]);
                const f32x4 d = e + 1.0f;
                f32x4 r; r[0] = __builtin_amdgcn_rcpf(d[0]); r[1] = __builtin_amdgcn_rcpf(d[1]); r[2] = __builtin_amdgcn_rcpf(d[2]); r[3] = __builtin_amdgcn_rcpf(d[3]);
                o[n] = gu * (r * iv2); }
            *(u32x4*)(H + (size_t)(row >> 11) * BBS + (size_t)(row & 2047) * DFF + ch0) = pack8(o[0], o[1]); }
    }
};
}

struct Frame {
    LAS unsigned char* lds;
    volatile LAS unsigned* MISC;
    gu32* ctl;
    int tid, lane, wave, vcu, G;
    const float *x, *norm_mix_g, *norm_ffn_g, *w_in, *fnet_map, *conv_w, *conv_b, *ln_g, *ln_b, *w_out, *pool_map, *pool_scale, *w_gate, *w_up, *w_down, *final_g;
    float* out; float* ssq;
    bf16_t *WinT, *WoT, *WguT, *WdT, *PmT, *DM, *XBa, *XBb, *AT, *U, *YQ, *HID;
};

struct TrItem { const float* W; int ldw, ks0, cs0; const float* kscale; bf16_t* Dst; int ldd, dr0, dc0; };
__device__ __forceinline__ void tr_load(const TrItem& t, float (&v)[32], int lane) {
    const GAS float* src = (const GAS float*)(t.W + (size_t)t.ks0 * t.ldw + t.cs0 + lane);
#pragma unroll
    for (int i = 0; i < 32; ++i) v[i] = src[(size_t)i * t.ldw];
}
__device__ __forceinline__ void tr_store(const TrItem& t, float (&v)[32], int lane) {
    if (t.kscale) {
#pragma unroll
        for (int i = 0; i < 32; ++i) v[i] *= t.kscale[t.ks0 + i]; }
    GAS u32x4* dst = (GAS u32x4*)(t.Dst + (size_t)(t.dr0 + lane) * t.ldd + t.dc0);
#pragma unroll
    for (int c = 0; c < 4; ++c) { u32x4 o; o.x = pk2(v[8 * c + 0], v[8 * c + 1]); o.y = pk2(v[8 * c + 2], v[8 * c + 3]); o.z = pk2(v[8 * c + 4], v[8 * c + 5]); o.w = pk2(v[8 * c + 6], v[8 * c + 7]); dst[c] = o; }
}
typedef float f32x16 __attribute__((ext_vector_type(16)));
__device__ __forceinline__ void p0_fold_item(Frame& F, int item) {
    const int nb = item & 31, h = item >> 5; int tid = F.tid; asm volatile("" : "+v"(tid));
    LAS float* Ml = (LAS float*)(F.lds);
    LAS float* Wl = Ml + 128 * 129;
    LAS float* Rl = Wl + 128 * 32;
    LAS float* Tl = Rl + 128 * 32;
    const float* Mh = F.fnet_map + (size_t)h * 128 * 128;
    {
        float mv[32], wv8[8];
#pragma unroll
        for (int k = 0; k < 32; ++k) mv[k] = Mh[tid + k * (NWAVES * 64)];
#pragma unroll
        for (int k = 0; k < 8; ++k) { const int i = tid + k * (NWAVES * 64), e = i >> 5, n = i & 31; wv8[k] = F.w_out[(size_t)(h * 128 + e) * D + nb * 32 + n]; }
#pragma unroll
        for (int k = 0; k < 32; ++k) { const int i = tid + k * (NWAVES * 64), l = i >> 7, e = i & 127; Ml[l * 129 + e] = mv[k]; }
#pragma unroll
        for (int k = 0; k < 8; ++k) Wl[tid + k * (NWAVES * 64)] = wv8[k];
    }
    if (tid < 128) Tl[tid] = cospif((float)tid * (1.0f / 64.0f));
    __syncthreads();
    const int lane = tid & 63, wv = tid >> 6, li = lane & 31, lk = lane >> 5;
    if (wv < 4) {
        f32x16 acc;
#pragma unroll
        for (int i = 0; i < 16; ++i) acc[i] = 0.f;
        const LAS float* ap = Ml + (32 * wv + li) * 129 + lk; const LAS float* bp = Wl + lk * 32 + li;
#pragma unroll 8
        for (int ks = 0; ks < 64; ++ks) acc = __builtin_amdgcn_mfma_f32_32x32x2f32(ap[2 * ks], bp[2 * ks * 32], acc, 0, 0, 0);
#pragma unroll
        for (int r = 0; r < 16; ++r) Rl[(32 * wv + (r & 3) + 8 * (r >> 2) + 4 * lk) * 32 + li] = acc[r];
    }
    __syncthreads();
    {
        const int cs = wv >> 2, d = 32 * (wv & 3) + li, sh = cs ? 32 : 0;
        f32x16 acc;
#pragma unroll
        for (int i = 0; i < 16; ++i) acc[i] = 0.f;
        const LAS float* bp = Rl + lk * 32 + li;
#pragma unroll 8
        for (int ks = 0; ks < 64; ++ks) { const int l = 2 * ks + lk; acc = __builtin_amdgcn_mfma_f32_32x32x2f32(Tl[(l * d - sh) & 127], bp[2 * ks * 32], acc, 0, 0, 0); }
        const float sc = cs ? (-1.0f / 512.0f) : (1.0f / 512.0f);
        bf16_t* orow = F.WoT + (size_t)(nb * 32 + li) * KOUT + cs * 512 + h * 128 + 32 * (wv & 3) + 4 * lk;
#pragma unroll
        for (int g = 0; g < 4; ++g) { u32x2 w; w.x = pk2(acc[4 * g] * sc, acc[4 * g + 1] * sc); w.y = pk2(acc[4 * g + 2] * sc, acc[4 * g + 3] * sc); *(GAS u32x2*)(orow + 8 * g) = w; }
    }
    __syncthreads();
}
constexpr int WI_IN = 32 * 24, WI_WO = 16 * 16, WI_GU = 32 * 44, WI_D = 88 * 16, WI_PM = 4 * 8 * 4, WI_L = 2 * WI_GU + WI_D;
constexpr int WI_LT = 4096;
constexpr int WI_N0 = WI_IN + WI_WO + WI_L + WI_PM, WI_ALL = WI_N0 + WI_L;
__device__ __forceinline__ TrItem weight_desc(const Frame& F, int it) {
    int r = it;
    if (r < WI_IN) { const int kb = r / 24, cb = r % 24, c0 = 64 * cb; int dr;
        if (c0 < 512) dr = c0; else if (c0 < 1024) { const int ch = c0 - 512; dr = 512 + 256 * (ch >> 7) + (ch & 127); } else { const int ch = c0 - 1024; dr = 512 + 256 * (ch >> 7) + 128 + (ch & 127); }
        return TrItem{F.w_in, INAB, 32 * kb, c0, nullptr, F.WinT, 1024, dr, 32 * kb}; } r -= WI_IN;
    if (r < WI_WO) { const int kb = r / 16, cb = r % 16; return TrItem{F.w_out, D, 512 + 32 * kb, 64 * cb, nullptr, F.WoT, KOUT, 64 * cb, 1024 + 32 * kb}; } r -= WI_WO;
    int l = 0;
    if (r >= WI_L) { r -= WI_L;
        if (r < WI_PM) { const int g = r >> 5, q = r & 31, kb = q >> 2, cb = q & 3; return TrItem{F.pool_map + (size_t)g * 65536, 256, 32 * kb, 64 * cb, nullptr, F.PmT + (size_t)g * 65536, 256, 64 * cb, 32 * kb}; }
        r -= WI_PM; l = 1; }
    if (r < 2 * WI_GU) { const int up = r / WI_GU; r -= up * WI_GU; const int kb = r / 44, cb = r % 44, ch = 64 * cb;
        return TrItem{(up ? F.w_up : F.w_gate) + (size_t)l * D * DFF, DFF, 32 * kb, ch, F.norm_ffn_g + l * D, F.WguT + (size_t)l * 5632 * 1024, 1024, 256 * (ch >> 7) + 128 * up + (ch & 127), 32 * kb}; }
    r -= 2 * WI_GU; const int kb = r / 16, cb = r % 16;
    return TrItem{F.w_down + (size_t)l * DFF * D, D, 32 * kb, 64 * cb, nullptr, F.WdT + (size_t)l * 1024 * DFF, DFF, 64 * cb, 32 * kb};
}
constexpr int WI_P0 = WI_IN + WI_WO + WI_PM + 2 * (WI_L - WI_LT);
__device__ __forceinline__ int p0_item(int i) {
    if (i < WI_IN + WI_WO) return i; i -= WI_IN + WI_WO;
    if (i < WI_PM) return WI_IN + WI_WO + WI_L + i; i -= WI_PM;
    if (i < WI_L - WI_LT) return WI_IN + WI_WO + WI_LT + i; i -= WI_L - WI_LT;
    return WI_N0 + WI_LT + i;
}
__device__ __forceinline__ void weight_items(const Frame& F, int first, int end, int stride) {
    for (int it = first; it < end; it += 4 * stride) {
        const bool h1 = it + stride < end, h2 = it + 2 * stride < end, h3 = it + 3 * stride < end;
        const TrItem t0 = weight_desc(F, it), t1 = weight_desc(F, h1 ? it + stride : it), t2 = weight_desc(F, h2 ? it + 2 * stride : it), t3 = weight_desc(F, h3 ? it + 3 * stride : it);
        float v0[32], v1[32], v2[32], v3[32];
        tr_load(t0, v0, F.lane); if (h1) tr_load(t1, v1, F.lane); if (h2) tr_load(t2, v2, F.lane); if (h3) tr_load(t3, v3, F.lane);
        tr_store(t0, v0, F.lane); if (h1) tr_store(t1, v1, F.lane); if (h2) tr_store(t2, v2, F.lane); if (h3) tr_store(t3, v3, F.lane);
    }
}
__device__ __forceinline__ bool idle_slot(const Frame& F, int nwg, int& j, int& n) {
    const int rounds = (nwg + F.G - 1) / F.G, nbusy = nwg - (rounds - 1) * F.G, bx = (int)blockIdx.x;
    if (nbusy >= F.G) { j = bx; n = F.G; return true; }
    if (bx < nbusy) return false;
    j = bx - nbusy; n = F.G - nbusy; return true;
}
__device__ __forceinline__ void p0_prologue(Frame& F) {
    const int gw = F.vcu * NWAVES + F.wave, NGW = F.G * NWAVES;
    const int bx = (int)blockIdx.x; const bool f256 = (F.G == 256), foldwg = f256 && bx < 128;
    if (foldwg) p0_fold_item(F, bx);
    LAS float* tab = (LAS float*)F.lds;
    for (int i = F.tid; i < 2048; i += NWAVES * 64) tab[i] = cospif((float)i * (1.0f / 1024.0f));
    __syncthreads();
    const bool wi_has = gw < WI_P0;
    const TrItem wi_t = weight_desc(F, p0_item(wi_has ? gw : 0));
    float wi_v[32];
    if (wi_has) tr_load(wi_t, wi_v, F.lane);
    int didx = F.vcu * (NWAVES * 64) + F.tid; const int dstep = F.G * NWAVES * 64;
    const int it0 = f256 ? (foldwg ? bx * NWAVES + F.wave : 3072 + (bx - 128) * NWAVES + F.wave) : gw, itend = foldwg ? 3072 : BATCH * 1024, itstep = f256 ? 1024 : NGW;
    for (int it = it0; it < itend; it += itstep) {
        const int b = it >> 10, q = it & 1023, sa = q, sb = q ? (SEQ - q) : (SEQ / 2);
        const size_t ra = (size_t)(b * SEQ + sa) * D, rb = (size_t)(b * SEQ + sb) * D;
        const GAS f32x4* xr0 = (const GAS f32x4*)(F.x + ra) + F.lane;
        const GAS f32x4* xr1 = (const GAS f32x4*)(F.x + rb) + F.lane;
        const GAS f32x4* gr = (const GAS f32x4*)(F.norm_mix_g) + F.lane;
        f32x4 v0[4], v1[4], g[4]; float s0 = 0.f, s1 = 0.f;
#pragma unroll
        for (int j = 0; j < 4; ++j) { v0[j] = xr0[64 * j]; v1[j] = xr1[64 * j]; g[j] = gr[64 * j]; }
        if (didx < 4096 * 128) { const int row = didx >> 7, c0 = (didx & 127) * 8, kr = row & 2047, sh = (row >= 2048) ? 512 : 0;
            float v[8];
#pragma unroll
            for (int j = 0; j < 8; ++j) v[j] = tab[(kr * (c0 + j) - sh) & 2047];
            u32x4 w; w.x = pk2(v[0], v[1]); w.y = pk2(v[2], v[3]); w.z = pk2(v[4], v[5]); w.w = pk2(v[6], v[7]);
            *(GAS u32x4*)(F.DM + (size_t)row * 1024 + c0) = w; didx += dstep; }
#pragma unroll
        for (int j = 0; j < 4; ++j) { s0 += (v0[j].x * v0[j].x + v0[j].y * v0[j].y) + (v0[j].z * v0[j].z + v0[j].w * v0[j].w); s1 += (v1[j].x * v1[j].x + v1[j].y * v1[j].y) + (v1[j].z * v1[j].z + v1[j].w * v1[j].w); }
        const float i0 = 1.0f / sqrtf(wave_sum(s0) * (1.0f / D) + RMS_EPS), i1 = 1.0f / sqrtf(wave_sum(s1) * (1.0f / D) + RMS_EPS);
        GAS unsigned long long* o0 = (GAS unsigned long long*)(F.XBa + ra) + F.lane;
        GAS unsigned long long* o1 = (GAS unsigned long long*)(F.XBa + rb) + F.lane;
        GAS unsigned long long* f0 = (GAS unsigned long long*)(F.XBb + (size_t)((b * 2 + 0) * 1024 + q) * D) + F.lane;
        GAS unsigned long long* f1 = (GAS unsigned long long*)(F.XBb + (size_t)((b * 2 + 1) * 1024 + q) * D) + F.lane;
#pragma unroll
        for (int j = 0; j < 4; ++j) { const f32x4 ha = v0[j] * g[j] * i0, hb = v1[j] * g[j] * i1;
            o0[64 * j] = (unsigned long long)pk2(ha.x, ha.y) | ((unsigned long long)pk2(ha.z, ha.w) << 32);
            o1[64 * j] = (unsigned long long)pk2(hb.x, hb.y) | ((unsigned long long)pk2(hb.z, hb.w) << 32);
            const f32x4 fs = q ? (ha + hb) : ha, fd = q ? (ha - hb) : hb;
            f0[64 * j] = (unsigned long long)pk2(fs.x, fs.y) | ((unsigned long long)pk2(fs.z, fs.w) << 32);
            f1[64 * j] = (unsigned long long)pk2(fd.x, fd.y) | ((unsigned long long)pk2(fd.z, fd.w) << 32); }
    }
    if (wi_has) tr_store(wi_t, wi_v, F.lane);
    for (int i = gw + NGW; i < WI_P0; i += NGW) { const TrItem t = weight_desc(F, p0_item(i)); float v[32]; tr_load(t, v, F.lane); tr_store(t, v, F.lane); }
    for (; didx < 4096 * 128; didx += dstep) {
        const int row = didx >> 7, c0 = (didx & 127) * 8, kr = row & 2047, sh = (row >= 2048) ? 512 : 0;
        float v[8];
#pragma unroll
        for (int j = 0; j < 8; ++j) v[j] = tab[(kr * (c0 + j) - sh) & 2047];
        u32x4 w; w.x = pk2(v[0], v[1]); w.y = pk2(v[2], v[3]); w.z = pk2(v[4], v[5]); w.w = pk2(v[6], v[7]);
        *(GAS u32x4*)(F.DM + (size_t)row * 1024 + c0) = w;
    }
    __syncthreads();
}

__device__ __forceinline__ void conv_tile(Frame& F, int tile) {
    const int t0 = tile * 64, b = t0 >> 11, s0 = t0 & 2047; int tid = F.tid; asm volatile("" : "+v"(tid));
    const int hh = F.wave & 3, th = F.wave >> 2, c = hh * 128 + 2 * F.lane;
    f32x2 w[31];
#pragma unroll
    for (int j = 0; j < 31; ++j) w[j] = *(const GAS f32x2*)(F.conv_w + j * 512 + c);
    const f32x2 cb = *(const GAS f32x2*)(F.conv_b + c), lg = *(const GAS f32x2*)(F.ln_g + c), lb = *(const GAS f32x2*)(F.ln_b + c);
    { u32x4 sv[12];
#pragma unroll
      for (int i = 0; i < 12; ++i) { const int idx = tid + i * 512, r = idx >> 6, c16 = idx & 63, s = s0 - 15 + r;
          sv[i] = (r < 94 && s >= 0 && s < SEQ) ? *(const GAS u32x4*)(F.U + (size_t)b * BBS + (size_t)s * 512 + c16 * 8) : (u32x4){0u, 0u, 0u, 0u}; }
#pragma unroll
      for (int i = 0; i < 12; ++i) { const int idx = tid + i * 512, r = idx >> 6, c16 = idx & 63; if (r < 94) *(LAS u32x4*)(F.lds + r * 1024 + c16 * 16) = sv[i]; } }
    asm volatile("" : "+v"(w[0]), "+v"(w[30]));
    __syncthreads();
    for (int chunk = 0; chunk < 2; ++chunk) {
        const int tb = th * 32 + chunk * 16;
        unsigned pv[46];
#pragma unroll
        for (int rr = 0; rr < 46; ++rr) pv[rr] = *(const LAS unsigned*)(F.lds + (tb + rr) * 1024 + c * 2);
        f32x2 acc[16];
#pragma unroll
        for (int t = 0; t < 16; ++t) acc[t] = cb;
#pragma unroll
        for (int rr = 0; rr < 46; ++rr) {
            const f32x2 v = (f32x2){bf_lo(pv[rr]), bf_hi(pv[rr])};
#pragma unroll
            for (int t = 0; t < 16; ++t) { const int j = rr - t; if (j >= 0 && j < 31) acc[t] += w[j] * v; }
        }
        float mean[16], var[16];
#pragma unroll
        for (int t = 0; t < 16; ++t) mean[t] = wave_sum(acc[t].x + acc[t].y) * (1.0f / 128.0f);
#pragma unroll
        for (int t = 0; t < 16; ++t) { acc[t].x -= mean[t]; acc[t].y -= mean[t]; var[t] = wave_sum(acc[t].x * acc[t].x + acc[t].y * acc[t].y) * (1.0f / 128.0f); }
#pragma unroll
        for (int t = 0; t < 16; ++t) {
            const float rstd = __builtin_amdgcn_rsqf(var[t] + LN_EPS);
            const float y0 = acc[t].x * rstd * lg.x + lb.x, y1 = acc[t].y * rstd * lg.y + lb.y;
            const float o0 = y0 * fast_sigmoid(y0), o1 = y1 * fast_sigmoid(y1);
            *(GAS unsigned*)(F.YQ + (size_t)b * BBS + (size_t)(s0 + tb + t) * KOUT + 1024 + c) = pk2(o0, o1);
        }
    }
    __syncthreads();
}

__device__ __forceinline__ void pool_tile(Frame& F, int tile, const float* ssq) {
    const int tt = tile >> 2, gi = tile & 3, t0 = tt * 64, b = t0 >> 11, s0 = t0 & 2047, tid = F.tid;
    LAS float* hL = (LAS float*)F.lds;
    LAS float* invL = hL + 80 * 256;
    const bf16_t* xg = F.XBb + (size_t)b * SEQ * D + gi * 256;
    u32x4 xv[5];
#pragma unroll
    for (int i = 0; i < 5; ++i) { const int e = tid + i * 512, r = e >> 5, c8 = e & 31, s = s0 - 8 + r;
        xv[i] = (s >= 0 && s < SEQ) ? *(const GAS u32x4*)(xg + (size_t)s * D + c8 * 8) : (u32x4){0u, 0u, 0u, 0u}; }
    if (tid < 80) { const int s = s0 - 8 + tid; float inv = 0.f;
        if (s >= 0 && s < SEQ) { const GAS f32x4* sp = (const GAS f32x4*)(ssq + (size_t)(b * SEQ + s) * 16); const f32x4 a = sp[0], bq = sp[1], cq = sp[2], dq = sp[3];
            const float tot = ((a[0] + a[1]) + (a[2] + a[3])) + ((bq[0] + bq[1]) + (bq[2] + bq[3])) + ((cq[0] + cq[1]) + (cq[2] + cq[3])) + ((dq[0] + dq[1]) + (dq[2] + dq[3]));
            inv = 1.0f / sqrtf(tot * (1.0f / D) + RMS_EPS); }
        invL[tid] = inv; }
    __syncthreads();
    { const f32x4 ga = *(const GAS f32x4*)(F.norm_mix_g + D + gi * 256 + (tid & 31) * 8), gb = *(const GAS f32x4*)(F.norm_mix_g + D + gi * 256 + (tid & 31) * 8 + 4);
#pragma unroll
      for (int i = 0; i < 5; ++i) { const int e = tid + i * 512, r = e >> 5, c8 = e & 31; const u32x4 h = xv[i]; const float iv = invL[r];
          *(LAS f32x4*)(hL + r * 256 + c8 * 8) = (f32x4){bf_lo(h.x), bf_hi(h.x), bf_lo(h.y), bf_hi(h.y)} * ga * iv;
          *(LAS f32x4*)(hL + r * 256 + c8 * 8 + 4) = (f32x4){bf_lo(h.z), bf_hi(h.z), bf_lo(h.w), bf_hi(h.w)} * gb * iv; } }
    __syncthreads();
    const int cp = tid & 127, tq = tid >> 7, w = 2 << gi, half = w >> 1;
    const LAS f32x2* hp = (const LAS f32x2*)hL + cp;
    const int i0 = tq * 16;
    f32x2 S = (f32x2){0.f, 0.f};
    for (int r = i0 + 8 - half; r < i0 + 8 - half + w; ++r) S += hp[r * 128];
    bf16_t* orow = F.XBa + (size_t)(b * SEQ + s0 + i0) * D + gi * 256 + cp * 2;
    for (int i = 0; i < 16; ++i) {
        const int t = s0 + i0 + i, r = i0 + i + 8; const int lo = (t - half) < 0 ? 0 : (t - half), hi = (t - half + w) > SEQ ? SEQ : (t - half + w);
        const float rc = 1.0f / (float)(hi - lo);
        const f32x2 h = hp[r * 128];
        const f32x2 pg = S * rc - h;
        *(GAS unsigned*)(orow + (size_t)i * D) = pk2(pg.x, pg.y);
        S += hp[(r - half + w) * 128]; S -= hp[(r - half) * 128];
    }
    __syncthreads();
}

__device__ __forceinline__ void poolmix_phase(Frame& F, const float* ssq_in, float* ssq_out, int tile0, int tstep, int tcount) {
    int tid = F.tid; asm volatile("" : "+v"(tid));
    LAS float* hL = (LAS float*)F.lds;
    LAS float* invL = hL + 80 * 256;
    LAS unsigned char* pgL = F.lds + 82432;
    LAS float* partL = (LAS float*)(F.lds + 82432 + 32768);
    const int lane = tid & 63, wv = F.wave, fr = lane & 15, fq = lane >> 4;
    const int ntile = 4 * (MTOK / 64);
    int tile = tile0; if (tile >= ntile || tcount <= 0) return;
    const int gi = tile & 3; const bool same_g = (tstep & 3) == 0;
    bf16x8 Bf[2][8];
#define PM_LOAD_B(g_) do { const bf16_t* pm_ = F.PmT + (size_t)(g_) * 65536; _Pragma("unroll") for (int nt = 0; nt < 2; ++nt) { const bf16_t* rp_ = pm_ + (size_t)(32 * wv + pg8::perm32(16 * nt + fr)) * 256 + 8 * fq; \
        _Pragma("unroll") for (int ks = 0; ks < 8; ++ks) Bf[nt][ks] = *(const GAS bf16x8*)(rp_ + 32 * ks); } } while (0)
    PM_LOAD_B(gi);
    u32x4 xv[5];
#define PM_LOAD_X(tl_) do { const int tt_ = (tl_) >> 2, g_ = (tl_) & 3, t0_ = tt_ * 64, b_ = t0_ >> 11, s0_ = t0_ & 2047; const bf16_t* xg_ = F.XBb + (size_t)b_ * SEQ * D + g_ * 256; \
        _Pragma("unroll") for (int i = 0; i < 5; ++i) { const int e = tid + i * 512, r = e >> 5, c8 = e & 31, s = s0_ - 8 + r; \
            xv[i] = (s >= 0 && s < SEQ) ? *(const GAS u32x4*)(xg_ + (size_t)s * D + c8 * 8) : (u32x4){0u, 0u, 0u, 0u}; } } while (0)
    PM_LOAD_X(tile);
    for (int tk = 0; tk < tcount && tile < ntile; ++tk, tile += tstep) {
        const int g = tile & 3, tt = tile >> 2, t0 = tt * 64, b = t0 >> 11, s0 = t0 & 2047;
        if (!same_g) PM_LOAD_B(g);
        if (tid < 80) { const int s = s0 - 8 + tid; float inv = 0.f;
            if (s >= 0 && s < SEQ) { const GAS f32x4* sp = (const GAS f32x4*)(ssq_in + (size_t)(b * SEQ + s) * 16); const f32x4 a = sp[0], bq = sp[1], cq = sp[2], dq = sp[3];
                const float tot = ((a[0] + a[1]) + (a[2] + a[3])) + ((bq[0] + bq[1]) + (bq[2] + bq[3])) + ((cq[0] + cq[1]) + (cq[2] + cq[3])) + ((dq[0] + dq[1]) + (dq[2] + dq[3]));
                inv = 1.0f / sqrtf(tot * (1.0f / D) + RMS_EPS); }
            invL[tid] = inv; }
        __syncthreads();
        { const f32x4 ga = *(const GAS f32x4*)(F.norm_mix_g + D + g * 256 + (tid & 31) * 8), gb = *(const GAS f32x4*)(F.norm_mix_g + D + g * 256 + (tid & 31) * 8 + 4);
#pragma unroll
          for (int i = 0; i < 5; ++i) { const int e = tid + i * 512, r = e >> 5, c8 = e & 31; const u32x4 h = xv[i]; const float iv = invL[r];
              *(LAS f32x4*)(hL + r * 256 + c8 * 8) = (f32x4){bf_lo(h.x), bf_hi(h.x), bf_lo(h.y), bf_hi(h.y)} * ga * iv;
              *(LAS f32x4*)(hL + r * 256 + c8 * 8 + 4) = (f32x4){bf_lo(h.z), bf_hi(h.z), bf_lo(h.w), bf_hi(h.w)} * gb * iv; } }
        const int col0 = g * 256 + 32 * wv + 8 * fq;
        if (tk + 1 < tcount && tile + tstep < ntile) PM_LOAD_X(tile + tstep);
        __syncthreads();
        { const int cp = tid & 127, tq = tid >> 7, w = 2 << g, half = w >> 1;
          const LAS f32x2* hp = (const LAS f32x2*)hL + cp;
          const int i0 = tq * 16;
          f32x2 S = (f32x2){0.f, 0.f};
          for (int r = i0 + 8 - half; r < i0 + 8 - half + w; ++r) S += hp[r * 128];
#pragma unroll 4
          for (int i = 0; i < 16; ++i) {
              const int tok = i0 + i, t = s0 + tok, r = tok + 8; const int lo = (t - half) < 0 ? 0 : (t - half), hi = (t - half + w) > SEQ ? SEQ : (t - half + w);
              const float rc = __builtin_amdgcn_rcpf((float)(hi - lo));
              const f32x2 h = hp[r * 128];
              const f32x2 pg = S * rc - h;
              *(LAS unsigned*)(pgL + tok * 512 + ((((cp >> 2) ^ (tok & 15))) << 4) + (cp & 3) * 4) = pk2(pg.x, pg.y);
              S += hp[(r - half + w) * 128]; S -= hp[(r - half) * 128];
          } }
        __syncthreads();
        u32x4 hx[4];
#pragma unroll
        for (int m = 0; m < 4; ++m) hx[m] = *(const GAS u32x4*)(F.XBb + (size_t)(b * SEQ + s0 + 16 * m + fr) * D + col0);
        f32x4 acc[4][2];
#pragma unroll
        for (int m = 0; m < 4; ++m)
#pragma unroll
            for (int nt = 0; nt < 2; ++nt) acc[m][nt] = (f32x4){0.f, 0.f, 0.f, 0.f};
#pragma unroll
        for (int ks = 0; ks < 8; ++ks) {
#pragma unroll
            for (int m = 0; m < 4; ++m) { const bf16x8 Af = *(const LAS bf16x8*)(pgL + (16 * m + fr) * 512 + (((4 * ks + fq) ^ fr) << 4));
#pragma unroll
                for (int nt = 0; nt < 2; ++nt) acc[m][nt] = __builtin_amdgcn_mfma_f32_16x16x32_bf16(Bf[nt][ks], Af, acc[m][nt], 0, 0, 0); }
            if (ks & 1) __builtin_amdgcn_sched_barrier(0);
        }
        { const f32x4 sc0 = *(const GAS f32x4*)(F.pool_scale + col0), sc1 = *(const GAS f32x4*)(F.pool_scale + col0 + 4);
#pragma unroll
          for (int m = 0; m < 4; ++m) { const int tok = 16 * m + fr; const size_t off = (size_t)(b * SEQ + s0 + tok) * D + col0; const u32x4 h = hx[m];
              const f32x4 o0 = (f32x4){bf_lo(h.x), bf_hi(h.x), bf_lo(h.y), bf_hi(h.y)} + sc0 * acc[m][0], o1 = (f32x4){bf_lo(h.z), bf_hi(h.z), bf_lo(h.w), bf_hi(h.w)} + sc1 * acc[m][1];
              *(GAS u32x4*)(F.XBa + off) = pg8::pack8(o0, o1);
              float sq = (o0[0] * o0[0] + o0[1] * o0[1]) + (o0[2] * o0[2] + o0[3] * o0[3]) + (o1[0] * o1[0] + o1[1] * o1[1]) + (o1[2] * o1[2] + o1[3] * o1[3]);
              sq += __shfl_xor(sq, 16); sq += __shfl_xor(sq, 32);
              if (fq == 0) partL[wv * 64 + tok] = sq; } }
        __syncthreads();
        if (tid < 256) { const int r = tid >> 2, q = tid & 3; ssq_out[(size_t)(b * SEQ + s0 + r) * 16 + g * 4 + q] = partL[(2 * q) * 64 + r] + partL[(2 * q + 1) * 64 + r]; }
    }
#undef PM_LOAD_B
#undef PM_LOAD_X
    __syncthreads();
}

struct Args { const float* in[16]; float* out; unsigned char* ws; int ph_lo, ph_hi; };
__global__ void __launch_bounds__(NWAVES * 64, 2) fwd_mega(Args args) {
    extern __shared__ __attribute__((aligned(16))) unsigned char lds[];
    Frame F;
    F.lds = (LAS unsigned char*)lds;
    F.MISC = (volatile LAS unsigned*)(F.lds + MISC_OFF);
    F.tid = threadIdx.x; F.lane = F.tid & 63; F.wave = __builtin_amdgcn_readfirstlane(F.tid >> 6);
    F.G = gridDim.x; { const int bx = blockIdx.x; F.vcu = (F.G % 8 == 0) ? (bx % 8) * (F.G / 8) + bx / 8 : bx; }
    unsigned char* ws = args.ws;
    F.ctl = (gu32*)(ws + WS_CTL);
    F.x = args.in[0]; F.norm_mix_g = args.in[1]; F.norm_ffn_g = args.in[2]; F.w_in = args.in[3]; F.fnet_map = args.in[4]; F.conv_w = args.in[5]; F.conv_b = args.in[6];
    F.ln_g = args.in[7]; F.ln_b = args.in[8]; F.w_out = args.in[9]; F.pool_map = args.in[10]; F.pool_scale = args.in[11]; F.w_gate = args.in[12]; F.w_up = args.in[13]; F.w_down = args.in[14]; F.final_g = args.in[15];
    F.out = args.out; F.ssq = (float*)(ws + WS_SSQ);
    F.WinT = (bf16_t*)(ws + WS_WIN); F.WoT = (bf16_t*)(ws + WS_WO); F.WguT = (bf16_t*)(ws + WS_WGU); F.WdT = (bf16_t*)(ws + WS_WD); F.PmT = (bf16_t*)(ws + WS_PM); F.DM = (bf16_t*)(ws + WS_DM);
    F.XBa = (bf16_t*)(ws + WS_XBA); F.XBb = (bf16_t*)(ws + WS_XBB); F.AT = (bf16_t*)(ws + WS_AT); F.U = (bf16_t*)(ws + WS_U); F.YQ = (bf16_t*)(ws + WS_YQ); F.HID = (bf16_t*)(ws + WS_HID);
    for (int u = F.tid; u < (STASH_OFF - LDSCTL_OFF) / 4; u += NWAVES * 64) ((LAS unsigned*)(F.lds + LDSCTL_OFF))[u] = 0u;
    __syncthreads();
    XcdBarrier bar; bar.bar = (unsigned*)(F.ctl + CW_BAR); bar.x = 0; bar.st = nullptr;
#if !MK_SPLIT
    bar = xcd_barrier_post((unsigned*)(F.ctl + CW_BAR), F.MISC + 8);
#endif
    const int lo = args.ph_lo, hi = args.ph_hi;
#define IN(k) (lo <= (k) && (k) < hi)
#if MK_SPLIT
#define SEAM(k) do { } while (0)
#else
#define SEAM(k) do { if (IN(k) && IN((k) + 1)) { if ((k) == 0) xcd_barrier<true>(bar); else if (MODE_LOC && ((k) == 1 || (k) == 3 || (k) == 4 || (k) == 5 || (k) == 7 || (k) == 8)) grp_barrier((unsigned*)F.ctl, LG, (unsigned)(F.G >> 3), F.MISC + 12); else xcd_barrier<false>(bar); } } while (0)
#endif
    const int bx = (int)blockIdx.x;
    const bool MODE_LOC = (F.G == 256); const unsigned LG = (unsigned)bx & 7u; const int LJ = bx >> 3;
#if !MK_SPLIT
    if (F.tid == 0) __hip_atomic_store((unsigned*)(F.ctl + CW_XID) + bx, 1u + xb_xcc_id(), __ATOMIC_RELAXED, __HIP_MEMORY_SCOPE_AGENT);
#endif
#define STAMP(k) do { if (DIAG_PH >= 0 && blockIdx.x == 0 && F.tid == 0) F.MISC[16 + (k)] = (unsigned)__builtin_amdgcn_s_memrealtime(); } while (0)
    STAMP(0);

#define REPS(k) ((PROBE_PH == (k)) ? (1 + PROBE_REP) : 1)
#define FOR_REP(k) _Pragma("unroll") for (int rep = 0, nrep = REPS(k); rep < nrep; ++rep)
#define DRY (rep + 1 < nrep)
    FOR_REP(0) { if (IN(0)) { p0_prologue(F); } SEAM(0); } STAMP(1);
#if !MK_SPLIT
    if (MODE_LOC && F.tid == 0) { const unsigned mine = 1u + xb_xcc_id(); unsigned same = 1u;
        for (int j = 0; j < 32; ++j) same &= (__hip_atomic_load((unsigned*)(F.ctl + CW_XID) + (int)LG + 8 * j, __ATOMIC_RELAXED, __HIP_MEMORY_SCOPE_AGENT) == mine) ? 1u : 0u;
        F.MISC[12] = same; }
#endif
    FOR_REP(1) {
        if (IN(1)) {
            pg8::ProbIn p; p.init(64, 6, F.G, bx); p.K = 1024; p.lda = 1024; p.ldb = 1024; p.kmult = (PROBE_KMULT_PH == 1) ? PROBE_KMULT : 1; p.X = F.XBa; p.XF = F.XBb; p.WinT = F.WinT; p.AT = F.AT; p.U = F.U;
            pg8::gemm_phase<pg8::ProbIn, true>(F.lds, p);
            { int j, n; const bool idle = idle_slot(F, 384, j, n);
              if (idle) weight_items(F, WI_IN + WI_WO + j * NWAVES + F.wave, WI_IN + WI_WO + WI_LT, n * NWAVES);
              if (F.G == 256) { }
              else if (idle && n == F.G) { for (int it = j; it < 128; it += n) p0_fold_item(F, it); }
              else if (!idle) { const int nbusy = 384 - ((384 + F.G - 1) / F.G - 1) * F.G; for (int it = bx; it < 128; it += nbusy) p0_fold_item(F, it); } }
        }
        SEAM(1); } STAMP(2);
    FOR_REP(2) {
        if (IN(2)) {
            pg8::ProbDft p; p.init(16, 16, F.G, bx); p.K = 1024; p.lda = 1024; p.ldb = 1024; p.DM = F.DM; p.AT = F.AT; p.YQ = F.YQ; p.loc = MODE_LOC; p.lg = (int)LG; p.lj = LJ; p.mult = PROBE_DFT_MULT; p.kmult = (PROBE_KMULT_PH == 2) ? PROBE_KMULT : 1;
            pg8::gemm_phase<pg8::ProbDft, true>(F.lds, p);
            if (MODE_LOC) conv_tile(F, (int)LG * 32 + LJ);
            else for (int t = F.vcu; t < PROBE_CONV_MULT * (MTOK / 64); t += F.G) conv_tile(F, t % (MTOK / 64));
        }
        SEAM(2); } STAMP(3);
    FOR_REP(3) {
        if (IN(3)) {
            pg8::ProbRes<false, false, true> p; p.init(64, 4, F.G, bx); p.kmult = (PROBE_KMULT_PH == 3) ? PROBE_KMULT : 1; p.K = KOUT; p.lda = KOUT; p.ldb = KOUT; p.A = F.YQ; p.Bt = F.WoT; p.a_bs = BBS; p.a_pm = (size_t)256 * KOUT; p.a_pn = 0; p.b_pn = (size_t)256 * KOUT;
            p.base = F.x; p.out = F.XBb; p.scale = nullptr; p.ssq = F.ssq;
            pg8::gemm_phase<pg8::ProbRes<false, false, true>, true>(F.lds, p);
        }
        SEAM(3); } STAMP(4);
#pragma unroll
    for (int l = 0; l < 2; ++l) {
        const int pb = l ? 7 : 4;
        FOR_REP(pb) {
            if (IN(pb)) {
                pg8::ProbGlu p; p.init(64, 22, F.G, bx); p.kmult = (PROBE_KMULT_PH == pb) ? PROBE_KMULT : 1; p.K = 1024; p.lda = 1024; p.ldb = 1024; p.A = l ? F.XBa : F.XBb; p.Bt = F.WguT + (size_t)l * 5632 * 1024; p.ssq = F.ssq + (size_t)(2 * l) * MTOK * 16; p.H = F.HID;
                const bool hm = MODE_LOC && l == 1;
                if (hm) p.nwg = 1280;
                pg8::gemm_phase<pg8::ProbGlu, true>(F.lds, p);
                if (hm) { pg8::ProbGluH q; q.init(64, 22, F.G, bx); q.K = 1024; q.lda = 1024; q.ldb = 1024; q.A = p.A; q.Bt = p.Bt; q.ssq = p.ssq; q.H = p.H;
                          pg8::gemm_phase<pg8::ProbGluH, true, true>(F.lds, q); }
                if (l == 0) { int j, n; if (idle_slot(F, 64 * 22, j, n)) weight_items(F, WI_N0 + j * NWAVES + F.wave, WI_N0 + WI_LT, n * NWAVES); }
            }
            SEAM(pb); } STAMP(pb + 1);
        FOR_REP(pb + 1) {
            if (IN(pb + 1)) {
                if (l == 0) {
                    pg8::ProbRes<false, true, true> p; p.init(64, 4, F.G, bx); p.kmult = (PROBE_KMULT_PH == pb + 1) ? PROBE_KMULT : 1; p.K = DFF; p.lda = DFF; p.ldb = DFF; p.A = F.HID; p.Bt = F.WdT; p.a_bs = BBS; p.a_pm = (size_t)256 * DFF; p.a_pn = 0; p.b_pn = (size_t)256 * DFF;
                    p.base = F.XBb; p.out = DRY ? (void*)(ws + WS_END) : (void*)F.XBb; p.scale = nullptr; p.ssq = DRY ? (float*)(ws + WS_END + 32 * MiB) : F.ssq + (size_t)1 * MTOK * 16;
                    pg8::gemm_phase<pg8::ProbRes<false, true, true>, true>(F.lds, p);
                } else {
                    pg8::ProbRes<false, true, true> p; p.init(64, 4, F.G, bx); p.kmult = (PROBE_KMULT_PH == pb + 1) ? PROBE_KMULT : 1; p.K = DFF; p.lda = DFF; p.ldb = DFF; p.A = F.HID; p.Bt = F.WdT + (size_t)1024 * DFF; p.a_bs = BBS; p.a_pm = (size_t)256 * DFF; p.a_pn = 0; p.b_pn = (size_t)256 * DFF;
                    p.base = F.XBa; p.out = DRY ? (void*)(ws + WS_END) : (void*)F.XBa; p.scale = nullptr; p.ssq = DRY ? (float*)(ws + WS_END + 32 * MiB) : F.ssq + (size_t)3 * MTOK * 16;
                    pg8::gemm_phase<pg8::ProbRes<false, true, true>, true>(F.lds, p);
                }
            }
            SEAM(pb + 1); } STAMP(pb + 2);
        if (l == 0) {
            FOR_REP(6) { if (IN(6)) { if (MODE_LOC) poolmix_phase(F, F.ssq + (size_t)1 * MTOK * 16, F.ssq + (size_t)2 * MTOK * 16, 4 * (32 * (int)LG + (LJ >> 2)) + (LJ & 3), 32, 4);
                else poolmix_phase(F, F.ssq + (size_t)1 * MTOK * 16, F.ssq + (size_t)2 * MTOK * 16, F.vcu, F.G, 4 * (MTOK / 64)); } SEAM(6); } STAMP(7);
        }
    }
    FOR_REP(9) {
        if (IN(9)) {
            const float* ssq = F.ssq + (size_t)3 * MTOK * 16;
            float* dst = DRY ? (float*)(ws + WS_XBA) : F.out;
            const int gw = MODE_LOC ? LJ * NWAVES + F.wave : F.vcu * NWAVES + F.wave, NGW = MODE_LOC ? 256 : F.G * NWAVES, mlo = MODE_LOC ? (int)LG * SEQ : 0, mhi = MODE_LOC ? mlo + SEQ : MTOK;
            float dA = 0.f;
            if (DIAG_PH >= 0 && blockIdx.x == 0) { __syncthreads(); dA = (float)(F.MISC[16 + DIAG_PH + 1] - F.MISC[16 + DIAG_PH]) * 0.01f * DIAG_SCALE; }
            for (int m = mlo + gw; m < mhi; m += 2 * NGW) {
                const int m1 = (m + NGW < mhi) ? m + NGW : m;
                const GAS u32x4* xr0 = (const GAS u32x4*)(F.XBa + (size_t)m * D) + F.lane;
                const GAS u32x4* xr1 = (const GAS u32x4*)(F.XBa + (size_t)m1 * D) + F.lane;
                const float* gr = F.final_g + 8 * F.lane;
                u32x4 h0[2], h1[2]; f32x4 g[2][2];
#pragma unroll
                for (int j = 0; j < 2; ++j) { h0[j] = xr0[64 * j]; h1[j] = xr1[64 * j]; g[j][0] = *(const GAS f32x4*)(gr + 512 * j); g[j][1] = *(const GAS f32x4*)(gr + 512 * j + 4); }
                const float pv0 = (F.lane < 16) ? ssq[(size_t)m * 16 + F.lane] : 0.f, pv1 = (F.lane < 16) ? ssq[(size_t)m1 * 16 + F.lane] : 0.f;
                const float inv0 = 1.0f / sqrtf(wave_sum(pv0) * (1.0f / D) + RMS_EPS), inv1 = 1.0f / sqrtf(wave_sum(pv1) * (1.0f / D) + RMS_EPS);
                float* y0 = dst + (size_t)m * D + 8 * F.lane; float* y1 = dst + (size_t)m1 * D + 8 * F.lane;
#pragma unroll
                for (int j = 0; j < 2; ++j) {
                    f32x4 o0 = (f32x4){bf_lo(h0[j].x), bf_hi(h0[j].x), bf_lo(h0[j].y), bf_hi(h0[j].y)} * inv0 * g[j][0]; const f32x4 o1 = (f32x4){bf_lo(h0[j].z), bf_hi(h0[j].z), bf_lo(h0[j].w), bf_hi(h0[j].w)} * inv0 * g[j][1];
                    if (DIAG_PH >= 0 && m == 0 && F.lane == 0 && j == 0) o0.x += dA;
                    *(GAS f32x4*)(y0 + 512 * j) = o0; *(GAS f32x4*)(y0 + 512 * j + 4) = o1;
                    if (m1 != m) { *(GAS f32x4*)(y1 + 512 * j) = (f32x4){bf_lo(h1[j].x), bf_hi(h1[j].x), bf_lo(h1[j].y), bf_hi(h1[j].y)} * inv1 * g[j][0];
                                   *(GAS f32x4*)(y1 + 512 * j + 4) = (f32x4){bf_lo(h1[j].z), bf_hi(h1[j].z), bf_lo(h1[j].w), bf_hi(h1[j].w)} * inv1 * g[j][1]; } }
            }
        }
        if (DRY) { if (IN(9)) xcd_barrier<false>(bar); } }
#undef REPS
#undef FOR_REP
#undef DRY
#undef IN
#undef SEAM
}

extern "C" void kernel_launch(void* const* d_in, const int* in_sizes, int n_in, void* d_out, int out_size, void* d_ws, size_t ws_size, hipStream_t stream) {
    static int grid = 0;
    if (grid == 0) {
        if (n_in != 16 || in_sizes[0] != MTOK * D || out_size != MTOK * D || ws_size < WS_END) { fprintf(stderr, "kernel_launch: unexpected shapes (n_in %d, in0 %d, out %d, ws %zu)\n", n_in, n_in > 0 ? in_sizes[0] : -1, out_size, ws_size); grid = -1; return; }
        int dev = 0, cus = 0, per_cu = 0;
        if (hipGetDevice(&dev) != hipSuccess || hipDeviceGetAttribute(&cus, hipDeviceAttributeMultiprocessorCount, dev) != hipSuccess) { grid = -1; return; }
        if (hipFuncSetAttribute((const void*)fwd_mega, hipFuncAttributeMaxDynamicSharedMemorySize, LDS_BYTES) != hipSuccess) { fprintf(stderr, "kernel_launch: hipFuncSetAttribute failed\n"); grid = -1; return; }
        if (hipOccupancyMaxActiveBlocksPerMultiprocessor(&per_cu, (const void*)fwd_mega, NWAVES * 64, LDS_BYTES) != hipSuccess || per_cu < 1) { fprintf(stderr, "kernel_launch: occupancy query says %d blocks/CU\n", per_cu); per_cu = 1; }
        (void)hipGetLastError();
        grid = cus;
    }
    if (grid < 0) return;
    if (hipMemsetAsync((char*)d_ws + WS_CTL, 0, CTL_ZERO_BYTES, stream) != hipSuccess) { fprintf(stderr, "kernel_launch: memset failed\n"); return; }
    Args a{};
    for (int i = 0; i < 16; ++i) a.in[i] = (const float*)d_in[i];
    a.out = (float*)d_out; a.ws = (unsigned char*)d_ws;
#if MK_SPLIT
    for (int ph = 0; ph < N_PHASES; ++ph) { a.ph_lo = ph; a.ph_hi = ph + 1; hipLaunchKernelGGL(fwd_mega, dim3(grid), dim3(NWAVES * 64), LDS_BYTES, stream, a); }
#else
    a.ph_lo = 0; a.ph_hi = N_PHASES;
    hipLaunchKernelGGL(fwd_mega, dim3(grid), dim3(NWAVES * 64), LDS_BYTES, stream, a);
#endif
    const hipError_t le = hipPeekAtLastError();
    if (le != hipSuccess) fprintf(stderr, "kernel_launch: launch failed: %s\n", hipGetErrorName(le));
}
```

```cpp
#include <hip/hip_runtime.h>
#include <cstdio>
#include <cstdint>

#ifndef MK_SPLIT
#define MK_SPLIT 0
#endif

#ifndef PROBE_PH
#define PROBE_PH (-1)
#define PROBE_REP 0
#endif
#ifndef DIAG_PH
#define DIAG_PH (-1)
#define DIAG_SCALE 0.01f
#endif
#ifndef PROBE_EPI2
#define PROBE_EPI2 0
#endif
#ifndef PROBE_KMULT
#define PROBE_KMULT 1
#define PROBE_KMULT_PH (-1)
#endif
#ifndef PROBE_CONV_MULT
#define PROBE_CONV_MULT 1
#define PROBE_DFT_MULT 1
#endif
#define LAS __attribute__((address_space(3)))
#define GAS __attribute__((address_space(1)))
typedef unsigned short bf16_t;
typedef short bf16x8 __attribute__((ext_vector_type(8)));
typedef float f32x4 __attribute__((ext_vector_type(4)));
typedef float f32x2 __attribute__((ext_vector_type(2)));
typedef unsigned u32x4 __attribute__((ext_vector_type(4)));
typedef unsigned u32x2 __attribute__((ext_vector_type(2)));
typedef GAS unsigned gu32;

constexpr int BATCH = 8, SEQ = 2048, D = 1024, MTOK = BATCH * SEQ;
constexpr int INAB = 1536, DFF = 2816, KOUT = 1536;
constexpr float RMS_EPS = 1e-6f, LN_EPS = 1e-5f;
constexpr int NWAVES = 8;
constexpr int N_PHASES = 10;

constexpr size_t MiB = 1u << 20;
constexpr size_t WS_CTL = 0, CTL_ZERO_BYTES = 40960;
constexpr size_t WS_SSQ = 1 * MiB;
constexpr size_t WS_WIN = 5 * MiB;
constexpr size_t WS_WO = 8 * MiB;
constexpr size_t WS_WGU = 11 * MiB;
constexpr size_t WS_WD = 33 * MiB;
constexpr size_t WS_PM = 44 * MiB;
constexpr size_t WS_DM = 45 * MiB;
constexpr size_t WS_XBA = 61 * MiB;
constexpr size_t WS_XBB = 93 * MiB;
constexpr size_t WS_BB = 125 * MiB;
constexpr size_t BBS = 11 * MiB / 2;
constexpr size_t WS_AT = WS_BB;
constexpr size_t WS_U = WS_BB + 2 * MiB;
constexpr size_t WS_YQ = WS_BB + 4 * MiB;
constexpr size_t WS_HID = WS_BB;
constexpr size_t WS_END = 213 * MiB;
constexpr int CW_BAR = 4096;
constexpr int CW_XID = 8960;
constexpr int CW_GRP = 7680;

constexpr int RING_BYTES = 131072;
constexpr int LDSCTL_OFF = RING_BYTES, MISC_OFF = LDSCTL_OFF + 320;
constexpr int STASH_OFF = LDSCTL_OFF + 1024;
constexpr int INVTAB_OFF = STASH_OFF + 16384;
constexpr int LDS_BYTES = INVTAB_OFF + 1024;

#define LDS_WAIT() asm volatile("s_waitcnt lgkmcnt(0)" ::: "memory")
#define VM_WAIT() asm volatile("s_waitcnt vmcnt(0)" ::: "memory")
__device__ __forceinline__ unsigned f2bf(float f) { unsigned u = __builtin_bit_cast(unsigned, f); return (u + 0x7fffu + ((u >> 16) & 1u)) >> 16; }
__device__ __forceinline__ unsigned pk2(float lo, float hi) { return f2bf(lo) | (f2bf(hi) << 16); }
__device__ __forceinline__ unsigned cvt_pk_bf16(float lo, float hi) { unsigned r; asm volatile("v_cvt_pk_bf16_f32 %0, %1, %2" : "=v"(r) : "v"(lo), "v"(hi)); return r; }
__device__ __forceinline__ float bf_lo(unsigned w) { return __builtin_bit_cast(float, w << 16); }
__device__ __forceinline__ float bf_hi(unsigned w) { return __builtin_bit_cast(float, w & 0xffff0000u); }
__device__ __forceinline__ float wave_sum(float v) {
    v += __builtin_bit_cast(float, __builtin_amdgcn_update_dpp(0, __builtin_bit_cast(int, v), 0xB1, 0xf, 0xf, true));
    v += __builtin_bit_cast(float, __builtin_amdgcn_update_dpp(0, __builtin_bit_cast(int, v), 0x4E, 0xf, 0xf, true));
    v += __builtin_bit_cast(float, __builtin_amdgcn_update_dpp(0, __builtin_bit_cast(int, v), 0x141, 0xf, 0xf, true));
    v += __builtin_bit_cast(float, __builtin_amdgcn_update_dpp(0, __builtin_bit_cast(int, v), 0x140, 0xf, 0xf, true));
    { float a = v, b = v; asm("s_nop 1\n\tv_permlane16_swap_b32 %0, %1\n\ts_nop 1" : "+v"(a), "+v"(b)); v = a + b; }
    { float a = v, b = v; asm("s_nop 1\n\tv_permlane32_swap_b32 %0, %1\n\ts_nop 1" : "+v"(a), "+v"(b)); v = a + b; }
    return v;
}
__device__ __forceinline__ float fast_sigmoid(float g) { return __builtin_amdgcn_rcpf(1.0f + __builtin_amdgcn_exp2f(g * -1.44269504089f)); }

#define XB_TMO      128
#define XB_XCNT(j)  (256  + 64 * (j))
#define XB_XSUB(j)  (1280 + 64 * (j))
#define XB_XGEN(j)  (2304 + 64 * (j))
#define XB_TOP      3328
#define XB_TOPGEN   3392
#define XCD_BAR_WORDS 3456
#define XB_SPIN_CAP (1u << 18)
__device__ __forceinline__ unsigned xb_ld(unsigned* p)              { return __hip_atomic_load(p, __ATOMIC_RELAXED, __HIP_MEMORY_SCOPE_AGENT); }
__device__ __forceinline__ unsigned xb_add(unsigned* p, unsigned v) { return __hip_atomic_fetch_add(p, v, __ATOMIC_RELAXED, __HIP_MEMORY_SCOPE_AGENT); }
__device__ __forceinline__ unsigned xb_xcc_id() { return (unsigned)__builtin_amdgcn_s_getreg((3 << 11) | 20) & 0xFu; }
#define XB_SPIN(cond, bar) do { unsigned _sp = 0; while (cond) { __builtin_amdgcn_s_sleep(1); \
    if ((++_sp & 255u) == 0u) { if (xb_ld(&(bar)[XB_TMO])) break; if (_sp > XB_SPIN_CAP) { atomicAdd(&(bar)[XB_TMO], 1u); break; } } } } while (0)
struct XcdBarrier { unsigned* bar; unsigned x; volatile LAS unsigned* st; };
__device__ __forceinline__ XcdBarrier xcd_barrier_post(unsigned* bar, volatile LAS unsigned* st) {
    XcdBarrier b; b.bar = bar; b.x = xb_xcc_id(); b.st = st;
    if (threadIdx.x == 0) (void)xb_add(&bar[XB_XCNT(b.x)], 1u);
    return b;
}
__device__ __forceinline__ void xcd_barrier_complete(unsigned* bar, unsigned x, unsigned& nloc, unsigned& nx) {
    const unsigned G = gridDim.x * gridDim.y * gridDim.z;
    unsigned sum, cnt, mine, sp = 0u;
    for (;;) {
        sum = 0u; cnt = 0u; mine = 0u;
#pragma unroll
        for (unsigned j = 0; j < 16; ++j) { const unsigned c = xb_ld(&bar[XB_XCNT(j)]); sum += c; cnt += (c > 0u) ? 1u : 0u; mine = (j == x) ? c : mine; }
        if (sum == G) break;
        __builtin_amdgcn_s_sleep(1);
        if ((++sp & 255u) == 0u) { if (xb_ld(&bar[XB_TMO])) break; if (sp > XB_SPIN_CAP) { atomicAdd(&bar[XB_TMO], 1u); break; } }
    }
    nloc = mine > 0u ? mine : 1u; nx = cnt > 0u ? cnt : 1u;
}
template <bool FIRST>
__device__ __forceinline__ void xcd_barrier(const XcdBarrier& b) {
    asm volatile("s_waitcnt vmcnt(0)" ::: "memory");
    __syncthreads();
    if (threadIdx.x == 0) {
        unsigned* bar = b.bar;
        __builtin_amdgcn_s_waitcnt(0);
        unsigned nloc = b.st[0], nx = b.st[1];
        if (FIRST) { xcd_barrier_complete(bar, b.x, nloc, nx); b.st[0] = nloc; b.st[1] = nx; }
        const unsigned old = xb_add(&bar[XB_XSUB(b.x)], 1u);
        const unsigned gen = old / nloc;
        if (old + 1u == (gen + 1u) * nloc) {
            __builtin_amdgcn_fence(__ATOMIC_RELEASE, "agent");
            asm volatile("s_waitcnt vmcnt(0)" ::: "memory");
            const unsigned og = xb_add(&bar[XB_TOP], 1u);
            const unsigned tg = og / nx;
            if (og + 1u == (tg + 1u) * nx) xb_add(&bar[XB_TOPGEN], 1u);
            else XB_SPIN(xb_ld(&bar[XB_TOPGEN]) == tg, bar);
            __builtin_amdgcn_fence(__ATOMIC_ACQUIRE, "agent");
            xb_add(&bar[XB_XGEN(b.x)], 1u);
            asm volatile("s_waitcnt vmcnt(0)" ::: "memory");
        } else {
            XB_SPIN(xb_ld(&bar[XB_XGEN(b.x)]) == gen, bar);
            __builtin_amdgcn_fence(__ATOMIC_ACQUIRE, "agent");
            asm volatile("s_waitcnt vmcnt(0)" ::: "memory");
        }
    }
    __syncthreads();
}

__device__ __forceinline__ void grp_barrier(unsigned* ctl, unsigned g, unsigned n, volatile LAS unsigned* coloc) {
    asm volatile("s_waitcnt vmcnt(0)" ::: "memory");
    __syncthreads();
    if (threadIdx.x == 0) {
        unsigned* cnt = ctl + CW_GRP + 64 * g; unsigned* gen = ctl + CW_GRP + 64 * (8 + g);
        __builtin_amdgcn_s_waitcnt(0);
        if (coloc[0] == 0u) {
            __builtin_amdgcn_fence(__ATOMIC_RELEASE, "agent");
            asm volatile("s_waitcnt vmcnt(0)" ::: "memory"); }
        const unsigned old = xb_add(cnt, 1u), ge = old / n;
        if (old + 1u == (ge + 1u) * n) xb_add(gen, 1u);
        else { unsigned sp = 0; while (xb_ld(gen) == ge) { __builtin_amdgcn_s_sleep(1); if (++sp > (1u << 20)) break; } }
        __builtin_amdgcn_fence(__ATOMIC_ACQUIRE, "agent");
        asm volatile("s_waitcnt vmcnt(0)" ::: "memory");
    }
    __syncthreads();
}

namespace pg8 {
constexpr int BM = 256, BK = 64, HALF = 128, HTB = HALF * BK * 2, STAGE_BYTES = 8 * HTB, NXCD = 8, WGM = 8;
__host__ __device__ __forceinline__ int lds_byte(int r, int c) { const int st = (r >> 4) * 2 + (c >> 5), rr = r & 15, cc = c & 31, ob = rr * 64 + cc * 2; return st * 1024 + (ob ^ (((ob >> 9) & 1) << 5)); }
__host__ __device__ __forceinline__ void stage_rc(int b, int& R, int& C) { const int st = b / 1024, sb = b % 1024, swz = sb ^ (((sb >> 9) & 1) << 5); R = (st >> 1) * 16 + swz / 64; C = (st & 1) * 32 + (swz % 64) / 2; }
__host__ __device__ __forceinline__ int perm32(int rho) { const int n = rho >> 4, i = rho & 15; return 8 * (i >> 2) + 4 * n + (i & 3); }
struct Unit { int pm, pn; };
struct Order {
    int nM, nN, nwg, G, c, mult = 1, kmult = 1; bool epi2 = false;
    __device__ __forceinline__ void init(int nM_, int nN_, int G_, int c_) { nM = nM_; nN = nN_; nwg = nM * nN; G = G_; c = c_; }
    __device__ __forceinline__ bool next(int i, Unit& u) const {
        const long L = (long)i * G + c; if (L >= (long)nwg * mult) return false;
        if (nM == 64 && (G & 7) == 0 && mult == 1) {
            const int w = (int)L >> 3; u.pm = 8 * ((int)L & 7) + (w & 7); u.pn = w >> 3; return true; }
        int wgid = (int)(L % nwg); { const int q = nwg / NXCD, r = nwg % NXCD, xcd = wgid % NXCD, off = wgid / NXCD; wgid = (xcd < r ? xcd * (q + 1) : r * (q + 1) + (xcd - r) * q) + off; }
        const int nig = WGM * nN, gid = wgid / nig, fm = gid * WGM, gsz = (nM - fm) < WGM ? (nM - fm) : WGM;
        u.pm = fm + ((wgid % nig) % gsz); u.pn = (wgid % nig) / gsz; return true;
    }
};
template <class P, bool ALIGN_EPI, bool HM = false>
__device__ __forceinline__ void gemm_phase(LAS unsigned char* lds, const P& p) {
    int tid = threadIdx.x; asm volatile("" : "+v"(tid));
    const int wid = __builtin_amdgcn_readfirstlane(tid >> 6), lane = tid & 63, wr = wid >> 2, wc = wid & 3, fr = lane & 15, fq = lane >> 4;
    const int K = p.K, nt = K / BK;
    unsigned voffA[2], voffB[2];
#pragma unroll
    for (int i = 0; i < 2; ++i) { int R, C; stage_rc(tid * 16 + i * 8192, R, C); const int Rb = P::PERM ? ((R & ~31) + perm32(R & 31)) : R;
        voffA[i] = (unsigned)(R * p.lda + C) * 2u; voffB[i] = (unsigned)(Rb * p.ldb + C) * 2u; }
    const size_t kstep = (size_t)(BK * 2);
    const size_t hstepA = (size_t)HALF * p.lda * 2, hstepB = (size_t)HALF * p.ldb * 2;
    const unsigned ldsw = (unsigned)wid * 1024u;
    const int aoff = lds_byte(wr * 64 + fr, fq * 8), boff = lds_byte(wc * 32 + fr, fq * 8);
#define PG8_SA(b, h) (((b) * 2 + (h)) * HTB)
#define PG8_SB(b, h) ((4 + (b) * 2 + (h)) * HTB)
#define PG8_STAGE(bufoff, gbase, voff) do { _Pragma("unroll") for (int _i = 0; _i < 2; ++_i) \
        __builtin_amdgcn_global_load_lds((const unsigned*)((const char*)(gbase) + (voff)[_i]), (LAS unsigned*)(lds + (bufoff) + ldsw + _i * 8192), 16, 0, 0); } while (0)
#define PG8_LDA(dst, b, h) do { _Pragma("unroll") for (int m = 0; m < 4; ++m) _Pragma("unroll") for (int k = 0; k < 2; ++k) dst[m][k] = *(const LAS bf16x8*)(lds + PG8_SA(b, h) + aoff + m * 2048 + k * 1024); } while (0)
#define PG8_LDB(dst, b, h) do { _Pragma("unroll") for (int n = 0; n < 2; ++n) _Pragma("unroll") for (int k = 0; k < 2; ++k) dst[n][k] = *(const LAS bf16x8*)(lds + PG8_SB(b, h) + boff + n * 2048 + k * 1024); } while (0)
#define PG8_MMA(ai, bj, At, Bt) do { __builtin_amdgcn_s_setprio(1); _Pragma("unroll") for (int m = 0; m < 4; ++m) _Pragma("unroll") for (int n = 0; n < 2; ++n) _Pragma("unroll") for (int k = 0; k < 2; ++k) \
        acc[ai][bj][m][n] = __builtin_amdgcn_mfma_f32_16x16x32_bf16(Bt[n][k], At[m][k], acc[ai][bj][m][n], 0, 0, 0); __builtin_amdgcn_s_setprio(0); } while (0)
#define PG8_WAIT_V(n) asm volatile("s_waitcnt vmcnt(" #n ")" ::: "memory")
#define PG8_WAIT_L(n) asm volatile("s_waitcnt lgkmcnt(" #n ")" ::: "memory")
#define PG8_BAR __builtin_amdgcn_s_barrier()
#define PG8_SCHED __builtin_amdgcn_sched_barrier(0)
    Unit cur, nxt; int ui = 0;
    if (!p.next(0, cur)) return;
    f32x4 acc[2][2][4][2];
#pragma unroll
    for (int a = 0; a < 2; ++a)
#pragma unroll
        for (int b = 0; b < 2; ++b)
#pragma unroll
            for (int m = 0; m < 4; ++m)
#pragma unroll
                for (int n = 0; n < 2; ++n) acc[a][b][m][n] = (f32x4){0.f, 0.f, 0.f, 0.f};
    bf16x8 At[4][2], B0[2][2], B1[2][2];
    const char* cA = p.aptr(cur); const char* cB = p.bptr(cur);
    PG8_STAGE(PG8_SB(0, 0), cB, voffB); PG8_STAGE(PG8_SB(0, 1), cB + hstepB, voffB); PG8_STAGE(PG8_SA(0, 0), cA, voffA); if constexpr (!HM) PG8_STAGE(PG8_SA(0, 1), cA + hstepA, voffA);
    PG8_STAGE(PG8_SB(1, 0), cB + kstep, voffB); PG8_STAGE(PG8_SA(1, 0), cA + kstep, voffA); PG8_STAGE(PG8_SB(1, 1), cB + hstepB + kstep, voffB);
    if (wr == 1) PG8_BAR;
    if constexpr (HM) PG8_WAIT_V(6); else PG8_WAIT_V(8);
    PG8_BAR;
    PG8_BAR;
    for (;;) {
        const bool has_next = p.next(ui + 1, nxt);
        const char* nA = has_next ? p.aptr(nxt) : cA; const char* nB = has_next ? p.bptr(nxt) : cB;
#if PROBE_KMULT > 1
        for (int tt = 0; tt < nt * p.kmult; tt += 2) {
            const int t = tt % nt; const bool last = (tt == nt * p.kmult - 2);
            const char* a1 = cA + (size_t)(t + 1) * kstep;
            const char* a2 = last ? nA : cA + (size_t)((t + 2) % nt) * kstep; const char* b2 = last ? nB : cB + (size_t)((t + 2) % nt) * kstep;
#else
        for (int t = 0; t < nt; t += 2) {
            const bool last = (t == nt - 2);
            const char* a1 = cA + (size_t)(t + 1) * kstep;
            const char* a2 = last ? nA : cA + (size_t)(t + 2) * kstep; const char* b2 = last ? nB : cB + (size_t)(t + 2) * kstep;
#endif
            const char* a3 = a2 + kstep; const char* b3 = b2 + kstep;
            if constexpr (P::HAS_PRE) { if (last) p.pre(cur, lds, wid, lane); }
            PG8_LDB(B0, 0, 0); PG8_LDB(B1, 0, 1); PG8_SCHED; PG8_LDA(At, 0, 0); if constexpr (!HM) PG8_STAGE(PG8_SA(1, 1), a1 + hstepA, voffA);
            PG8_WAIT_V(8); PG8_WAIT_L(0); PG8_BAR; PG8_MMA(0, 0, At, B0); PG8_MMA(0, 1, At, B1); PG8_BAR; PG8_SCHED;
            if constexpr (!HM) PG8_LDA(At, 0, 1);
            PG8_STAGE(PG8_SB(0, 0), b2, voffB); PG8_STAGE(PG8_SB(0, 1), b2 + hstepB, voffB); PG8_STAGE(PG8_SA(0, 0), a2, voffA);
            if constexpr (HM) PG8_WAIT_V(6); else PG8_WAIT_V(8);
            PG8_WAIT_L(0); PG8_BAR; if constexpr (!HM) { PG8_MMA(1, 0, At, B0); PG8_MMA(1, 1, At, B1); } PG8_BAR; PG8_SCHED;
            PG8_LDB(B0, 1, 0); PG8_LDB(B1, 1, 1); PG8_SCHED; PG8_LDA(At, 1, 0); if constexpr (!HM) PG8_STAGE(PG8_SA(0, 1), a2 + hstepA, voffA);
            PG8_WAIT_V(8); PG8_WAIT_L(0); PG8_BAR; PG8_MMA(0, 0, At, B0); PG8_MMA(0, 1, At, B1); PG8_BAR; PG8_SCHED;
            if constexpr (!HM) PG8_LDA(At, 1, 1);
            PG8_STAGE(PG8_SB(1, 0), b3, voffB); PG8_STAGE(PG8_SB(1, 1), b3 + hstepB, voffB); PG8_STAGE(PG8_SA(1, 0), a3, voffA);
            if constexpr (HM) PG8_WAIT_V(6); else PG8_WAIT_V(8);
            PG8_WAIT_L(0); PG8_BAR; if constexpr (!HM) { PG8_MMA(1, 0, At, B0); PG8_MMA(1, 1, At, B1); } PG8_BAR; PG8_SCHED;
        }
        if constexpr (ALIGN_EPI) { if (wr == 0) PG8_BAR; }
#if PROBE_KMULT > 1
        if (p.kmult > 1) { const float sc_ = 1.0f / (float)p.kmult;
#pragma unroll
            for (int a = 0; a < 2; ++a)
#pragma unroll
                for (int b = 0; b < 2; ++b)
#pragma unroll
                    for (int m = 0; m < 4; ++m)
#pragma unroll
                        for (int n = 0; n < 2; ++n) acc[a][b][m][n] *= sc_; }
#endif
        p.epi(acc, cur, wr, wc, fr, fq, lds);
        if (PROBE_EPI2 && p.epi2) { asm volatile("" ::: "memory"); p.epi(acc, cur, wr, wc, fr, fq, lds); }
        if (!has_next) break;
#pragma unroll
        for (int a = 0; a < 2; ++a)
#pragma unroll
            for (int b = 0; b < 2; ++b)
#pragma unroll
                for (int m = 0; m < 4; ++m)
#pragma unroll
                    for (int n = 0; n < 2; ++n) acc[a][b][m][n] = (f32x4){0.f, 0.f, 0.f, 0.f};
        cur = nxt; cA = nA; cB = nB; ++ui;
        if constexpr (ALIGN_EPI) { if (wr == 1) PG8_BAR; }
    }
    PG8_WAIT_V(0);
    if constexpr (!ALIGN_EPI) { if (wr == 0) PG8_BAR; }
    PG8_BAR;
#undef PG8_SA
#undef PG8_SB
#undef PG8_STAGE
#undef PG8_LDA
#undef PG8_LDB
#undef PG8_MMA
#undef PG8_WAIT_V
#undef PG8_WAIT_L
#undef PG8_BAR
#undef PG8_SCHED
}

__device__ __forceinline__ u32x4 pack8(const f32x4 v0, const f32x4 v1) {
    u32x4 w; w.x = cvt_pk_bf16(v0[0], v0[1]); w.y = cvt_pk_bf16(v0[2], v0[3]); w.z = cvt_pk_bf16(v1[0], v1[1]); w.w = cvt_pk_bf16(v1[2], v1[3]); return w;
}

struct ProbIn : Order {
    static constexpr bool PERM = true, HAS_PRE = false;
    int K, lda, ldb;
    const bf16_t* X; const bf16_t* XF; const bf16_t* WinT; bf16_t* AT; bf16_t* U;
    __device__ __forceinline__ const char* aptr(const Unit& u) const { return u.pn >= 4 ? (const char*)(WinT + (size_t)(u.pn - 4) * 256 * 1024) : (const char*)(X + (size_t)u.pm * 256 * 1024); }
    __device__ __forceinline__ const char* bptr(const Unit& u) const { return u.pn >= 4 ? (const char*)(XF + (size_t)u.pm * 256 * 1024) : (const char*)(WinT + (size_t)(512 + u.pn * 256) * 1024); }
    __device__ __forceinline__ void epi(const f32x4 (&acc)[2][2][4][2], const Unit& u, int wr, int wc, int fr, int fq, LAS unsigned char* lds) const {
        if (u.pn >= 4) {
            const int tokc = u.pm * 256 + wc * 32 + 8 * fq;
#pragma unroll
            for (int ai = 0; ai < 2; ++ai)
#pragma unroll
                for (int m = 0; m < 4; ++m) { const int np = (u.pn - 4) * 256 + ai * 128 + wr * 64 + m * 16 + fr;
#pragma unroll
                    for (int bj = 0; bj < 2; ++bj) { const int tok = tokc + bj * 128, bcs = tok >> 10, s = tok & 1023;
                        *(u32x4*)(AT + (size_t)(bcs >> 1) * BBS + ((size_t)((bcs & 1) * 512 + np) * 1024 + s)) = pack8(acc[ai][bj][m][0], acc[ai][bj][m][1]); } }
        } else {
            const int ch0 = u.pn * 128 + wc * 32 + 8 * fq;
#pragma unroll
            for (int ai = 0; ai < 2; ++ai)
#pragma unroll
                for (int m = 0; m < 4; ++m) { const int row = u.pm * 256 + ai * 128 + wr * 64 + m * 16 + fr;
                    f32x4 o0, o1;
#pragma unroll
                    for (int j = 0; j < 4; ++j) { o0[j] = acc[ai][0][m][0][j] * fast_sigmoid(acc[ai][1][m][0][j]); o1[j] = acc[ai][0][m][1][j] * fast_sigmoid(acc[ai][1][m][1][j]); }
                    *(u32x4*)(U + (size_t)(row >> 11) * BBS + (size_t)(row & 2047) * 512 + ch0) = pack8(o0, o1); }
        }
    }
};
struct ProbDft : Order {
    static constexpr bool PERM = true, HAS_PRE = false;
    int K, lda, ldb;
    const bf16_t* DM; const bf16_t* AT; bf16_t* YQ; bool loc; int lg, lj;
    __device__ __forceinline__ bool next(int i, Unit& u) const { if (!loc) return Order::next(i, u); if (i > 0) return false; u.pm = lj & 15; u.pn = 2 * lg + (lj >> 4); return true; }
    __device__ __forceinline__ const char* aptr(const Unit& u) const { return (const char*)(DM + (size_t)u.pm * 256 * 1024); }
    __device__ __forceinline__ const char* bptr(const Unit& u) const { return (const char*)(AT + (size_t)(u.pn >> 1) * BBS + (size_t)((u.pm >> 3) * 512 + (u.pn & 1) * 256) * 1024); }
    __device__ __forceinline__ void epi(const f32x4 (&acc)[2][2][4][2], const Unit& u, int wr, int wc, int fr, int fq, LAS unsigned char* lds) const {
        const int cs = u.pm >> 3, b = u.pn >> 1, n0 = (u.pn & 1) * 256 + wc * 32 + 8 * fq;
        f32x4 e0[2], e1[2];
#pragma unroll
        for (int bj = 0; bj < 2; ++bj) { e0[bj] = (f32x4){0.f, 0.f, 0.f, 0.f}; e1[bj] = e0[bj]; }
        if (cs == 0) {
            const float sg = (fr & 1) ? -1.0f : 1.0f;
#pragma unroll
            for (int bj = 0; bj < 2; ++bj) { const bf16_t* ap = AT + (size_t)b * BBS + (size_t)(512 + n0 + bj * 128) * 1024;
#pragma unroll
                for (int j = 0; j < 4; ++j) { e0[bj][j] = sg * bf_lo((unsigned)ap[(size_t)j * 1024]); e1[bj][j] = sg * bf_lo((unsigned)ap[(size_t)(4 + j) * 1024]); } }
        }
#pragma unroll
        for (int ai = 0; ai < 2; ++ai)
#pragma unroll
            for (int m = 0; m < 4; ++m) { const int k = (u.pm & 7) * 256 + ai * 128 + wr * 64 + m * 16 + fr;
                bf16_t* rowp = YQ + (size_t)b * BBS + (size_t)k * KOUT + cs * 512 + n0;
#pragma unroll
                for (int bj = 0; bj < 2; ++bj) *(u32x4*)(rowp + bj * 128) = pack8(acc[ai][bj][m][0] + e0[bj], acc[ai][bj][m][1] + e1[bj]); }
    }
};
template <bool SCALE, bool BASEBF, bool OUTBF>
struct ProbRes : Order {
    static constexpr bool PERM = true, HAS_PRE = false;
    int K, lda, ldb;
    const bf16_t* A; const bf16_t* Bt; size_t a_bs, a_pm, a_pn, b_pn;
    const void* base; void* out; const float* scale; float* ssq;
    __device__ __forceinline__ const char* aptr(const Unit& u) const { return (const char*)(A + (size_t)(u.pm >> 3) * a_bs + (size_t)(u.pm & 7) * a_pm + (size_t)u.pn * a_pn); }
    __device__ __forceinline__ const char* bptr(const Unit& u) const { return (const char*)(Bt + (size_t)u.pn * b_pn); }
    __device__ __forceinline__ void epi(const f32x4 (&acc)[2][2][4][2], const Unit& u, int wr, int wc, int fr, int fq, LAS unsigned char* lds) const {
        const __amdgpu_buffer_rsrc_t rB = __builtin_amdgcn_make_buffer_rsrc((void*)base, 0, MTOK * D * (BASEBF ? 2 : 4), 0x00020000);
        const __amdgpu_buffer_rsrc_t rO = __builtin_amdgcn_make_buffer_rsrc((void*)out, 0, MTOK * D * (OUTBF ? 2 : 4), 0x00020000);
        const __amdgpu_buffer_rsrc_t rS = __builtin_amdgcn_make_buffer_rsrc((void*)ssq, 0, MTOK * 16 * 4, 0x00020000);
        const int vo = ((wr * 64 + fr) * D + wc * 32 + 8 * fq) * 4;
        const int vs = (wr * 64 + fr) * 64 + wc * 4;
        const int so0 = (u.pm * 256 * D + u.pn * 256) * 4;
        f32x4 sc[2][2];
        if (SCALE) {
            const int col0 = u.pn * 256 + wc * 32 + 8 * fq;
#pragma unroll
            for (int bj = 0; bj < 2; ++bj)
#pragma unroll
                for (int n = 0; n < 2; ++n) sc[bj][n] = *(const f32x4*)(scale + col0 + bj * 128 + 4 * n);
        }
        f32x4 bv[3][2][2]; u32x4 bh[3][2];
#define RES_SO(s, bj) (so0 + ((((s) >> 2) * 128 + ((s) & 3) * 16) * D + (bj) * 128) * 4)
#define RES_LOAD(s) do { _Pragma("unroll") for (int bj = 0; bj < 2; ++bj) { \
            if (BASEBF) bh[(s) % 3][bj] = __builtin_amdgcn_raw_buffer_load_b128(rB, vo >> 1, RES_SO(s, bj) >> 1, 0); \
            else { bv[(s) % 3][bj][0] = __builtin_bit_cast(f32x4, __builtin_amdgcn_raw_buffer_load_b128(rB, vo, RES_SO(s, bj), 0)); \
                   bv[(s) % 3][bj][1] = __builtin_bit_cast(f32x4, __builtin_amdgcn_raw_buffer_load_b128(rB, vo + 16, RES_SO(s, bj), 0)); } } } while (0)
        RES_LOAD(0); RES_LOAD(1);
#pragma unroll
        for (int s = 0; s < 8; ++s) {
            if (s + 2 < 8) RES_LOAD(s + 2);
            asm volatile("" ::: "memory");
            const int ai = s >> 2, m = s & 3;
            float sq = 0.f;
#pragma unroll
            for (int bj = 0; bj < 2; ++bj) {
                f32x4 b0, b1;
                if (BASEBF) { const u32x4 h = bh[s % 3][bj]; b0 = (f32x4){bf_lo(h.x), bf_hi(h.x), bf_lo(h.y), bf_hi(h.y)}; b1 = (f32x4){bf_lo(h.z), bf_hi(h.z), bf_lo(h.w), bf_hi(h.w)}; }
                else { b0 = bv[s % 3][bj][0]; b1 = bv[s % 3][bj][1]; }
                f32x4 o0, o1;
                if (SCALE) { o0 = b0 + acc[ai][bj][m][0] * sc[bj][0]; o1 = b1 + acc[ai][bj][m][1] * sc[bj][1]; }
                else { o0 = b0 + acc[ai][bj][m][0]; o1 = b1 + acc[ai][bj][m][1]; }
                if (OUTBF) *(u32x4*)((bf16_t*)out + (size_t)(u.pm * 256 + ai * 128 + wr * 64 + m * 16 + fr) * D + u.pn * 256 + bj * 128 + wc * 32 + 8 * fq) = pack8(o0, o1);
                else { __builtin_amdgcn_raw_buffer_store_b128(__builtin_bit_cast(u32x4, o0), rO, vo, RES_SO(s, bj), 0);
                       __builtin_amdgcn_raw_buffer_store_b128(__builtin_bit_cast(u32x4, o1), rO, vo + 16, RES_SO(s, bj), 0); }
                sq += (o0[0] * o0[0] + o0[1] * o0[1]) + (o0[2] * o0[2] + o0[3] * o0[3]) + (o1[0] * o1[0] + o1[1] * o1[1]) + (o1[2] * o1[2] + o1[3] * o1[3]);
            }
            sq += __shfl_xor(sq, 16); sq += __shfl_xor(sq, 32);
            if (fq == 0) __builtin_amdgcn_raw_buffer_store_b32(__builtin_bit_cast(unsigned, sq), rS, vs, (u.pm * 256 + ai * 128 + m * 16) * 64 + u.pn * 16, 0);
            asm volatile("" ::: "memory");
        }
#undef RES_LOAD
#undef RES_SO
    }
};
struct ProbGlu : Order {
    static constexpr bool PERM = true, HAS_PRE = true;
    int K, lda, ldb;
    const bf16_t* A; const bf16_t* Bt; const float* ssq; bf16_t* H;
    __device__ __forceinline__ const char* aptr(const Unit& u) const { return (const char*)(A + (size_t)u.pm * 256 * 1024); }
    __device__ __forceinline__ const char* bptr(const Unit& u) const { return (const char*)(Bt + (size_t)u.pn * 256 * 1024); }
    __device__ __forceinline__ void pre(const Unit& u, LAS unsigned char* lds, int wid, int lane) const {
        const char* src = (const char*)(ssq + (size_t)u.pm * 256 * 16) + wid * 2048 + lane * 16;
#pragma unroll
        for (int i = 0; i < 2; ++i) __builtin_amdgcn_global_load_lds((const unsigned*)(src + i * 1024), (LAS unsigned*)(lds + STASH_OFF + wid * 2048 + i * 1024), 16, 0, 0);
    }
    __device__ __forceinline__ void epi(const f32x4 (&acc)[2][2][4][2], const Unit& u, int wr, int wc, int fr, int fq, LAS unsigned char* lds) const {
        const int ch0 = u.pn * 128 + wc * 32 + 8 * fq;
        { const int t = threadIdx.x;
          if (t < 256) { const LAS f32x4* sp = (const LAS f32x4*)(lds + STASH_OFF + t * 64);
              const f32x4 s0 = sp[0], s1 = sp[1], s2 = sp[2], s3 = sp[3];
              const float tot = ((s0[0] + s0[1]) + (s0[2] + s0[3])) + ((s1[0] + s1[1]) + (s1[2] + s1[3])) + ((s2[0] + s2[1]) + (s2[2] + s2[3])) + ((s3[0] + s3[1]) + (s3[2] + s3[3]));
              ((LAS float*)(lds + INVTAB_OFF))[t] = 1.0f / sqrtf(tot * (1.0f / D) + RMS_EPS); }
          asm volatile("s_waitcnt lgkmcnt(0)" ::: "memory"); __builtin_amdgcn_s_barrier(); asm volatile("" ::: "memory"); }
        float inv[2][4];
#pragma unroll
        for (int ai = 0; ai < 2; ++ai)
#pragma unroll
            for (int m = 0; m < 4; ++m) inv[ai][m] = ((const LAS float*)(lds + INVTAB_OFF))[ai * 128 + wr * 64 + m * 16 + fr];
#pragma unroll
        for (int ai = 0; ai < 2; ++ai)
#pragma unroll
            for (int m = 0; m < 4; ++m) { const int row = u.pm * 256 + ai * 128 + wr * 64 + m * 16 + fr; const float iv = inv[ai][m];
                const float c1 = iv * -1.44269504089f, iv2 = iv * iv;
                f32x4 o[2];
#pragma unroll
                for (int n = 0; n < 2; ++n) { const f32x4 g = acc[ai][0][m][n], up = acc[ai][1][m][n]; const f32x4 t = g * c1, gu = g * up;
                    f32x4 e; e[0] = __builtin_amdgcn_exp2f(t[0]); e[1] = __builtin_amdgcn_exp2f(t[1]); e[2] = __builtin_amdgcn_exp2f(t[2]); e[3] = __builtin_amdgcn_exp2f(t[3]);
                    const f32x4 d = e + 1.0f;
                    f32x4 r; r[0] = __builtin_amdgcn_rcpf(d[0]); r[1] = __builtin_amdgcn_rcpf(d[1]); r[2] = __builtin_amdgcn_rcpf(d[2]); r[3] = __builtin_amdgcn_rcpf(d[3]);
                    o[n] = gu * (r * iv2); }
                *(u32x4*)(H + (size_t)(row >> 11) * BBS + (size_t)(row & 2047) * DFF + ch0) = pack8(o[0], o[1]); }
    }
};
struct ProbGluH : ProbGlu {
    __device__ __forceinline__ bool next(int i, Unit& u) const {
        if (i != 0) return false;
        const int L = 1280 + (c & 127), w = L >> 3; u.pm = 8 * (L & 7) + (w & 7); u.pn = w >> 3; return true;
    }
    __device__ __forceinline__ const char* aptr(const Unit& u) const { return (const char*)(A + ((size_t)u.pm * 256 + (size_t)(c >> 7) * 128) * 1024); }
    __device__ __forceinline__ void epi(const f32x4 (&acc)[2][2][4][2], const Unit& u, int wr, int wc, int fr, int fq, LAS unsigned char* lds) const {
        const int ch0 = u.pn * 128 + wc * 32 + 8 * fq, hf = c >> 7;
        { const int t = threadIdx.x;
          if (t < 256) { const LAS f32x4* sp = (const LAS f32x4*)(lds + STASH_OFF + t * 64);
              const f32x4 s0 = sp[0], s1 = sp[1], s2 = sp[2], s3 = sp[3];
              const float tot = ((s0[0] + s0[1]) + (s0[2] + s0[3])) + ((s1[0] + s1[1]) + (s1[2] + s1[3])) + ((s2[0] + s2[1]) + (s2[2] + s2[3])) + ((s3[0] + s3[1]) + (s3[2] + s3[3]));
              ((LAS float*)(lds + INVTAB_OFF))[t] = 1.0f / sqrtf(tot * (1.0f / D) + RMS_EPS); }
          asm volatile("s_waitcnt lgkmcnt(0)" ::: "memory"); __builtin_amdgcn_s_barrier(); asm volatile("" ::: "memory"); }
        float inv[4];
#pragma unroll
        for (int m = 0; m < 4; ++m) inv[m] = ((const LAS float*)(lds + INVTAB_OFF))[hf * 128 + wr * 64 + m * 16 + fr];
#pragma unroll
        for (int m = 0; m < 4; ++m) { const int row = u.pm * 256 + hf * 128 + wr * 64 + m * 16 + fr; const float iv = inv[m];
            const float c1 = iv * -1.44269504089f, iv2 = iv * iv;
            f32x4 o[2];
#pragma unroll
            for (int n = 0; n < 2; ++n) { const f32x4 g = acc[0][0][m][n], up = acc[0][1][m][n]; const f32x4 t = g * c1, gu = g * up;
                f32x4 e; e[0] = __builtin_amdgcn_exp2f(t[0]); e[1] = __builtin_amdgcn_exp2f(t[1]); e[2] = __builtin_amdgcn_exp2f(t[2]); e[3] = __builtin_amdgcn_exp2f(t[3]);
                const f32x4 d = e + 1.0f;
                f32x4 r; r[0] = __builtin_amdgcn_rcpf(d[0]); r[1] = __builtin_amdgcn_rcpf(d[1]); r[2] = __builtin_amdgcn_rcpf(d[2]); r[3] = __builtin_amdgcn_rcpf(d[3]);
                o[n] = gu * (r * iv2); }
            *(u32x4*)(H + (size_t)(row >> 11) * BBS + (size_t)(row & 2047) * DFF + ch0) = pack8(o[0], o[1]); }
    }
};
}

struct Frame {
    LAS unsigned char* lds;
    volatile LAS unsigned* MISC;
    gu32* ctl;
    int tid, lane, wave, vcu, G;
    const float *x, *norm_mix_g, *norm_ffn_g, *w_in, *fnet_map, *conv_w, *conv_b, *ln_g, *ln_b, *w_out, *pool_map, *pool_scale, *w_gate, *w_up, *w_down, *final_g;
    float* out; float* ssq;
    bf16_t *WinT, *WoT, *WguT, *WdT, *PmT, *DM, *XBa, *XBb, *AT, *U, *YQ, *HID;
};

struct TrItem { const float* W; int ldw, ks0, cs0; const float* kscale; bf16_t* Dst; int ldd, dr0, dc0; };
__device__ __forceinline__ void tr_load(const TrItem& t, float (&v)[32], int lane) {
    const GAS float* src = (const GAS float*)(t.W + (size_t)t.ks0 * t.ldw + t.cs0 + lane);
#pragma unroll
    for (int i = 0; i < 32; ++i) v[i] = src[(size_t)i * t.ldw];
}
__device__ __forceinline__ void tr_store(const TrItem& t, float (&v)[32], int lane) {
    if (t.kscale) {
#pragma unroll
        for (int i = 0; i < 32; ++i) v[i] *= t.kscale[t.ks0 + i]; }
    GAS u32x4* dst = (GAS u32x4*)(t.Dst + (size_t)(t.dr0 + lane) * t.ldd + t.dc0);
#pragma unroll
    for (int c = 0; c < 4; ++c) { u32x4 o; o.x = pk2(v[8 * c + 0], v[8 * c + 1]); o.y = pk2(v[8 * c + 2], v[8 * c + 3]); o.z = pk2(v[8 * c + 4], v[8 * c + 5]); o.w = pk2(v[8 * c + 6], v[8 * c + 7]); dst[c] = o; }
}
typedef float f32x16 __attribute__((ext_vector_type(16)));
__device__ __forceinline__ void p0_fold_item(Frame& F, int item) {
    const int nb = item & 31, h = item >> 5; int tid = F.tid; asm volatile("" : "+v"(tid));
    LAS float* Ml = (LAS float*)(F.lds);
    LAS float* Wl = Ml + 128 * 129;
    LAS float* Rl = Wl + 128 * 32;
    LAS float* Tl = Rl + 128 * 32;
    const float* Mh = F.fnet_map + (size_t)h * 128 * 128;
    {
        float mv[32], wv8[8];
#pragma unroll
        for (int k = 0; k < 32; ++k) mv[k] = Mh[tid + k * (NWAVES * 64)];
#pragma unroll
        for (int k = 0; k < 8; ++k) { const int i = tid + k * (NWAVES * 64), e = i >> 5, n = i & 31; wv8[k] = F.w_out[(size_t)(h * 128 + e) * D + nb * 32 + n]; }
#pragma unroll
        for (int k = 0; k < 32; ++k) { const int i = tid + k * (NWAVES * 64), l = i >> 7, e = i & 127; Ml[l * 129 + e] = mv[k]; }
#pragma unroll
        for (int k = 0; k < 8; ++k) Wl[tid + k * (NWAVES * 64)] = wv8[k];
    }
    if (tid < 128) Tl[tid] = cospif((float)tid * (1.0f / 64.0f));
    __syncthreads();
    const int lane = tid & 63, wv = tid >> 6, li = lane & 31, lk = lane >> 5;
    if (wv < 4) {
        f32x16 acc;
#pragma unroll
        for (int i = 0; i < 16; ++i) acc[i] = 0.f;
        const LAS float* ap = Ml + (32 * wv + li) * 129 + lk; const LAS float* bp = Wl + lk * 32 + li;
#pragma unroll 8
        for (int ks = 0; ks < 64; ++ks) acc = __builtin_amdgcn_mfma_f32_32x32x2f32(ap[2 * ks], bp[2 * ks * 32], acc, 0, 0, 0);
#pragma unroll
        for (int r = 0; r < 16; ++r) Rl[(32 * wv + (r & 3) + 8 * (r >> 2) + 4 * lk) * 32 + li] = acc[r];
    }
    __syncthreads();
    {
        const int cs = wv >> 2, d = 32 * (wv & 3) + li, sh = cs ? 32 : 0;
        f32x16 acc;
#pragma unroll
        for (int i = 0; i < 16; ++i) acc[i] = 0.f;
        const LAS float* bp = Rl + lk * 32 + li;
#pragma unroll 8
        for (int ks = 0; ks < 64; ++ks) { const int l = 2 * ks + lk; acc = __builtin_amdgcn_mfma_f32_32x32x2f32(Tl[(l * d - sh) & 127], bp[2 * ks * 32], acc, 0, 0, 0); }
        const float sc = cs ? (-1.0f / 512.0f) : (1.0f / 512.0f);
        bf16_t* orow = F.WoT + (size_t)(nb * 32 + li) * KOUT + cs * 512 + h * 128 + 32 * (wv & 3) + 4 * lk;
#pragma unroll
        for (int g = 0; g < 4; ++g) { u32x2 w; w.x = pk2(acc[4 * g] * sc, acc[4 * g + 1] * sc); w.y = pk2(acc[4 * g + 2] * sc, acc[4 * g + 3] * sc); *(GAS u32x2*)(orow + 8 * g) = w; }
    }
    __syncthreads();
}
constexpr int WI_IN = 32 * 24, WI_WO = 16 * 16, WI_GU = 32 * 44, WI_D = 88 * 16, WI_PM = 4 * 8 * 4, WI_L = 2 * WI_GU + WI_D;
constexpr int WI_LT = 4096;
constexpr int WI_N0 = WI_IN + WI_WO + WI_L + WI_PM, WI_ALL = WI_N0 + WI_L;
__device__ __forceinline__ TrItem weight_desc(const Frame& F, int it) {
    int r = it;
    if (r < WI_IN) { const int kb = r / 24, cb = r % 24, c0 = 64 * cb; int dr;
        if (c0 < 512) dr = c0; else if (c0 < 1024) { const int ch = c0 - 512; dr = 512 + 256 * (ch >> 7) + (ch & 127); } else { const int ch = c0 - 1024; dr = 512 + 256 * (ch >> 7) + 128 + (ch & 127); }
        return TrItem{F.w_in, INAB, 32 * kb, c0, nullptr, F.WinT, 1024, dr, 32 * kb}; } r -= WI_IN;
    if (r < WI_WO) { const int kb = r / 16, cb = r % 16; return TrItem{F.w_out, D, 512 + 32 * kb, 64 * cb, nullptr, F.WoT, KOUT, 64 * cb, 1024 + 32 * kb}; } r -= WI_WO;
    int l = 0;
    if (r >= WI_L) { r -= WI_L;
        if (r < WI_PM) { const int g = r >> 5, q = r & 31, kb = q >> 2, cb = q & 3; return TrItem{F.pool_map + (size_t)g * 65536, 256, 32 * kb, 64 * cb, nullptr, F.PmT + (size_t)g * 65536, 256, 64 * cb, 32 * kb}; }
        r -= WI_PM; l = 1; }
    if (r < 2 * WI_GU) { const int up = r / WI_GU; r -= up * WI_GU; const int kb = r / 44, cb = r % 44, ch = 64 * cb;
        return TrItem{(up ? F.w_up : F.w_gate) + (size_t)l * D * DFF, DFF, 32 * kb, ch, F.norm_ffn_g + l * D, F.WguT + (size_t)l * 5632 * 1024, 1024, 256 * (ch >> 7) + 128 * up + (ch & 127), 32 * kb}; }
    r -= 2 * WI_GU; const int kb = r / 16, cb = r % 16;
    return TrItem{F.w_down + (size_t)l * DFF * D, D, 32 * kb, 64 * cb, nullptr, F.WdT + (size_t)l * 1024 * DFF, DFF, 64 * cb, 32 * kb};
}
constexpr int WI_P0 = WI_IN + WI_WO + WI_PM + 2 * (WI_L - WI_LT);
__device__ __forceinline__ int p0_item(int i) {
    if (i < WI_IN + WI_WO) return i; i -= WI_IN + WI_WO;
    if (i < WI_PM) return WI_IN + WI_WO + WI_L + i; i -= WI_PM;
    if (i < WI_L - WI_LT) return WI_IN + WI_WO + WI_LT + i; i -= WI_L - WI_LT;
    return WI_N0 + WI_LT + i;
}
__device__ __forceinline__ void weight_items(const Frame& F, int first, int end, int stride) {
    for (int it = first; it < end; it += 4 * stride) {
        const bool h1 = it + stride < end, h2 = it + 2 * stride < end, h3 = it + 3 * stride < end;
        const TrItem t0 = weight_desc(F, it), t1 = weight_desc(F, h1 ? it + stride : it), t2 = weight_desc(F, h2 ? it + 2 * stride : it), t3 = weight_desc(F, h3 ? it + 3 * stride : it);
        float v0[32], v1[32], v2[32], v3[32];
        tr_load(t0, v0, F.lane); if (h1) tr_load(t1, v1, F.lane); if (h2) tr_load(t2, v2, F.lane); if (h3) tr_load(t3, v3, F.lane);
        tr_store(t0, v0, F.lane); if (h1) tr_store(t1, v1, F.lane); if (h2) tr_store(t2, v2, F.lane); if (h3) tr_store(t3, v3, F.lane);
    }
}
__device__ __forceinline__ bool idle_slot(const Frame& F, int nwg, int& j, int& n) {
    const int rounds = (nwg + F.G - 1) / F.G, nbusy = nwg - (rounds - 1) * F.G, bx = (int)blockIdx.x;
    if (nbusy >= F.G) { j = bx; n = F.G; return true; }
    if (bx < nbusy) return false;
    j = bx - nbusy; n = F.G - nbusy; return true;
}
__device__ __forceinline__ void p0_prologue(Frame& F) {
    const int gw = F.vcu * NWAVES + F.wave, NGW = F.G * NWAVES;
    const int bx = (int)blockIdx.x; const bool f256 = (F.G == 256), foldwg = f256 && bx < 128;
    if (foldwg) p0_fold_item(F, bx);
    LAS float* tab = (LAS float*)F.lds;
    for (int i = F.tid; i < 2048; i += NWAVES * 64) tab[i] = cospif((float)i * (1.0f / 1024.0f));
    __syncthreads();
    const bool wi_has = gw < WI_P0;
    const TrItem wi_t = weight_desc(F, p0_item(wi_has ? gw : 0));
    float wi_v[32];
    if (wi_has) tr_load(wi_t, wi_v, F.lane);
    int didx = F.vcu * (NWAVES * 64) + F.tid; const int dstep = F.G * NWAVES * 64;
    const int it0 = f256 ? (foldwg ? bx * NWAVES + F.wave : 3072 + (bx - 128) * NWAVES + F.wave) : gw, itend = foldwg ? 3072 : BATCH * 1024, itstep = f256 ? 1024 : NGW;
    for (int it = it0; it < itend; it += itstep) {
        const int b = it >> 10, q = it & 1023, sa = q, sb = q ? (SEQ - q) : (SEQ / 2);
        const size_t ra = (size_t)(b * SEQ + sa) * D, rb = (size_t)(b * SEQ + sb) * D;
        const GAS f32x4* xr0 = (const GAS f32x4*)(F.x + ra) + F.lane;
        const GAS f32x4* xr1 = (const GAS f32x4*)(F.x + rb) + F.lane;
        const GAS f32x4* gr = (const GAS f32x4*)(F.norm_mix_g) + F.lane;
        f32x4 v0[4], v1[4], g[4]; float s0 = 0.f, s1 = 0.f;
#pragma unroll
        for (int j = 0; j < 4; ++j) { v0[j] = xr0[64 * j]; v1[j] = xr1[64 * j]; g[j] = gr[64 * j]; }
        if (didx < 4096 * 128) { const int row = didx >> 7, c0 = (didx & 127) * 8, kr = row & 2047, sh = (row >= 2048) ? 512 : 0;
            float v[8];
#pragma unroll
            for (int j = 0; j < 8; ++j) v[j] = tab[(kr * (c0 + j) - sh) & 2047];
            u32x4 w; w.x = pk2(v[0], v[1]); w.y = pk2(v[2], v[3]); w.z = pk2(v[4], v[5]); w.w = pk2(v[6], v[7]);
            *(GAS u32x4*)(F.DM + (size_t)row * 1024 + c0) = w; didx += dstep; }
#pragma unroll
        for (int j = 0; j < 4; ++j) { s0 += (v0[j].x * v0[j].x + v0[j].y * v0[j].y) + (v0[j].z * v0[j].z + v0[j].w * v0[j].w); s1 += (v1[j].x * v1[j].x + v1[j].y * v1[j].y) + (v1[j].z * v1[j].z + v1[j].w * v1[j].w); }
        const float i0 = 1.0f / sqrtf(wave_sum(s0) * (1.0f / D) + RMS_EPS), i1 = 1.0f / sqrtf(wave_sum(s1) * (1.0f / D) + RMS_EPS);
        GAS unsigned long long* o0 = (GAS unsigned long long*)(F.XBa + ra) + F.lane;
        GAS unsigned long long* o1 = (GAS unsigned long long*)(F.XBa + rb) + F.lane;
        GAS unsigned long long* f0 = (GAS unsigned long long*)(F.XBb + (size_t)((b * 2 + 0) * 1024 + q) * D) + F.lane;
        GAS unsigned long long* f1 = (GAS unsigned long long*)(F.XBb + (size_t)((b * 2 + 1) * 1024 + q) * D) + F.lane;
#pragma unroll
        for (int j = 0; j < 4; ++j) { const f32x4 ha = v0[j] * g[j] * i0, hb = v1[j] * g[j] * i1;
            o0[64 * j] = (unsigned long long)pk2(ha.x, ha.y) | ((unsigned long long)pk2(ha.z, ha.w) << 32);
            o1[64 * j] = (unsigned long long)pk2(hb.x, hb.y) | ((unsigned long long)pk2(hb.z, hb.w) << 32);
            const f32x4 fs = q ? (ha + hb) : ha, fd = q ? (ha - hb) : hb;
            f0[64 * j] = (unsigned long long)pk2(fs.x, fs.y) | ((unsigned long long)pk2(fs.z, fs.w) << 32);
            f1[64 * j] = (unsigned long long)pk2(fd.x, fd.y) | ((unsigned long long)pk2(fd.z, fd.w) << 32); }
    }
    if (wi_has) tr_store(wi_t, wi_v, F.lane);
    for (int i = gw + NGW; i < WI_P0; i += NGW) { const TrItem t = weight_desc(F, p0_item(i)); float v[32]; tr_load(t, v, F.lane); tr_store(t, v, F.lane); }
    for (; didx < 4096 * 128; didx += dstep) {
        const int row = didx >> 7, c0 = (didx & 127) * 8, kr = row & 2047, sh = (row >= 2048) ? 512 : 0;
        float v[8];
#pragma unroll
        for (int j = 0; j < 8; ++j) v[j] = tab[(kr * (c0 + j) - sh) & 2047];
        u32x4 w; w.x = pk2(v[0], v[1]); w.y = pk2(v[2], v[3]); w.z = pk2(v[4], v[5]); w.w = pk2(v[6], v[7]);
        *(GAS u32x4*)(F.DM + (size_t)row * 1024 + c0) = w;
    }
    __syncthreads();
}

__device__ __forceinline__ void conv_tile(Frame& F, int tile) {
    const int t0 = tile * 64, b = t0 >> 11, s0 = t0 & 2047; int tid = F.tid; asm volatile("" : "+v"(tid));
    const int hh = F.wave & 3, th = F.wave >> 2, c = hh * 128 + 2 * F.lane;
    f32x2 w[31];
#pragma unroll
    for (int j = 0; j < 31; ++j) w[j] = *(const GAS f32x2*)(F.conv_w + j * 512 + c);
    const f32x2 cb = *(const GAS f32x2*)(F.conv_b + c), lg = *(const GAS f32x2*)(F.ln_g + c), lb = *(const GAS f32x2*)(F.ln_b + c);
    { u32x4 sv[12];
#pragma unroll
      for (int i = 0; i < 12; ++i) { const int idx = tid + i * 512, r = idx >> 6, c16 = idx & 63, s = s0 - 15 + r;
          sv[i] = (r < 94 && s >= 0 && s < SEQ) ? *(const GAS u32x4*)(F.U + (size_t)b * BBS + (size_t)s * 512 + c16 * 8) : (u32x4){0u, 0u, 0u, 0u}; }
#pragma unroll
      for (int i = 0; i < 12; ++i) { const int idx = tid + i * 512, r = idx >> 6, c16 = idx & 63; if (r < 94) *(LAS u32x4*)(F.lds + r * 1024 + c16 * 16) = sv[i]; } }
    asm volatile("" : "+v"(w[0]), "+v"(w[30]));
    __syncthreads();
    for (int chunk = 0; chunk < 2; ++chunk) {
        const int tb = th * 32 + chunk * 16;
        unsigned pv[46];
#pragma unroll
        for (int rr = 0; rr < 46; ++rr) pv[rr] = *(const LAS unsigned*)(F.lds + (tb + rr) * 1024 + c * 2);
        f32x2 acc[16];
#pragma unroll
        for (int t = 0; t < 16; ++t) acc[t] = cb;
#pragma unroll
        for (int rr = 0; rr < 46; ++rr) {
            const f32x2 v = (f32x2){bf_lo(pv[rr]), bf_hi(pv[rr])};
#pragma unroll
            for (int t = 0; t < 16; ++t) { const int j = rr - t; if (j >= 0 && j < 31) acc[t] += w[j] * v; }
        }
        float mean[16], var[16];
#pragma unroll
        for (int t = 0; t < 16; ++t) mean[t] = wave_sum(acc[t].x + acc[t].y) * (1.0f / 128.0f);
#pragma unroll
        for (int t = 0; t < 16; ++t) { acc[t].x -= mean[t]; acc[t].y -= mean[t]; var[t] = wave_sum(acc[t].x * acc[t].x + acc[t].y * acc[t].y) * (1.0f / 128.0f); }
#pragma unroll
        for (int t = 0; t < 16; ++t) {
            const float rstd = __builtin_amdgcn_rsqf(var[t] + LN_EPS);
            const float y0 = acc[t].x * rstd * lg.x + lb.x, y1 = acc[t].y * rstd * lg.y + lb.y;
            const float o0 = y0 * fast_sigmoid(y0), o1 = y1 * fast_sigmoid(y1);
            *(GAS unsigned*)(F.YQ + (size_t)b * BBS + (size_t)(s0 + tb + t) * KOUT + 1024 + c) = pk2(o0, o1);
        }
    }
    __syncthreads();
}

__device__ __forceinline__ void pool_tile(Frame& F, int tile, const float* ssq) {
    const int tt = tile >> 2, gi = tile & 3, t0 = tt * 64, b = t0 >> 11, s0 = t0 & 2047, tid = F.tid;
    LAS float* hL = (LAS float*)F.lds;
    LAS float* invL = hL + 80 * 256;
    const bf16_t* xg = F.XBb + (size_t)b * SEQ * D + gi * 256;
    u32x4 xv[5];
#pragma unroll
    for (int i = 0; i < 5; ++i) { const int e = tid + i * 512, r = e >> 5, c8 = e & 31, s = s0 - 8 + r;
        xv[i] = (s >= 0 && s < SEQ) ? *(const GAS u32x4*)(xg + (size_t)s * D + c8 * 8) : (u32x4){0u, 0u, 0u, 0u}; }
    if (tid < 80) { const int s = s0 - 8 + tid; float inv = 0.f;
        if (s >= 0 && s < SEQ) { const GAS f32x4* sp = (const GAS f32x4*)(ssq + (size_t)(b * SEQ + s) * 16); const f32x4 a = sp[0], bq = sp[1], cq = sp[2], dq = sp[3];
            const float tot = ((a[0] + a[1]) + (a[2] + a[3])) + ((bq[0] + bq[1]) + (bq[2] + bq[3])) + ((cq[0] + cq[1]) + (cq[2] + cq[3])) + ((dq[0] + dq[1]) + (dq[2] + dq[3]));
            inv = 1.0f / sqrtf(tot * (1.0f / D) + RMS_EPS); }
        invL[tid] = inv; }
    __syncthreads();
    { const f32x4 ga = *(const GAS f32x4*)(F.norm_mix_g + D + gi * 256 + (tid & 31) * 8), gb = *(const GAS f32x4*)(F.norm_mix_g + D + gi * 256 + (tid & 31) * 8 + 4);
#pragma unroll
      for (int i = 0; i < 5; ++i) { const int e = tid + i * 512, r = e >> 5, c8 = e & 31; const u32x4 h = xv[i]; const float iv = invL[r];
          *(LAS f32x4*)(hL + r * 256 + c8 * 8) = (f32x4){bf_lo(h.x), bf_hi(h.x), bf_lo(h.y), bf_hi(h.y)} * ga * iv;
          *(LAS f32x4*)(hL + r * 256 + c8 * 8 + 4) = (f32x4){bf_lo(h.z), bf_hi(h.z), bf_lo(h.w), bf_hi(h.w)} * gb * iv; } }
    __syncthreads();
    const int cp = tid & 127, tq = tid >> 7, w = 2 << gi, half = w >> 1;
    const LAS f32x2* hp = (const LAS f32x2*)hL + cp;
    const int i0 = tq * 16;
    f32x2 S = (f32x2){0.f, 0.f};
    for (int r = i0 + 8 - half; r < i0 + 8 - half + w; ++r) S += hp[r * 128];
    bf16_t* orow = F.XBa + (size_t)(b * SEQ + s0 + i0) * D + gi * 256 + cp * 2;
    for (int i = 0; i < 16; ++i) {
        const int t = s0 + i0 + i, r = i0 + i + 8; const int lo = (t - half) < 0 ? 0 : (t - half), hi = (t - half + w) > SEQ ? SEQ : (t - half + w);
        const float rc = 1.0f / (float)(hi - lo);
        const f32x2 h = hp[r * 128];
        const f32x2 pg = S * rc - h;
        *(GAS unsigned*)(orow + (size_t)i * D) = pk2(pg.x, pg.y);
        S += hp[(r - half + w) * 128]; S -= hp[(r - half) * 128];
    }
    __syncthreads();
}

__device__ __forceinline__ void poolmix_phase(Frame& F, const float* ssq_in, float* ssq_out, int tile0, int tstep, int tcount) {
    int tid = F.tid; asm volatile("" : "+v"(tid));
    LAS float* hL = (LAS float*)F.lds;
    LAS float* invL = hL + 80 * 256;
    LAS unsigned char* pgL = F.lds + 82432;
    LAS float* partL = (LAS float*)(F.lds + 82432 + 32768);
    const int lane = tid & 63, wv = F.wave, fr = lane & 15, fq = lane >> 4;
    const int ntile = 4 * (MTOK / 64);
    int tile = tile0; if (tile >= ntile || tcount <= 0) return;
    const int gi = tile & 3; const bool same_g = (tstep & 3) == 0;
    bf16x8 Bf[2][8];
#define PM_LOAD_B(g_) do { const bf16_t* pm_ = F.PmT + (size_t)(g_) * 65536; _Pragma("unroll") for (int nt = 0; nt < 2; ++nt) { const bf16_t* rp_ = pm_ + (size_t)(32 * wv + pg8::perm32(16 * nt + fr)) * 256 + 8 * fq; \
        _Pragma("unroll") for (int ks = 0; ks < 8; ++ks) Bf[nt][ks] = *(const GAS bf16x8*)(rp_ + 32 * ks); } } while (0)
    PM_LOAD_B(gi);
    u32x4 xv[5];
#define PM_LOAD_X(tl_) do { const int tt_ = (tl_) >> 2, g_ = (tl_) & 3, t0_ = tt_ * 64, b_ = t0_ >> 11, s0_ = t0_ & 2047; const bf16_t* xg_ = F.XBb + (size_t)b_ * SEQ * D + g_ * 256; \
        _Pragma("unroll") for (int i = 0; i < 5; ++i) { const int e = tid + i * 512, r = e >> 5, c8 = e & 31, s = s0_ - 8 + r; \
            xv[i] = (s >= 0 && s < SEQ) ? *(const GAS u32x4*)(xg_ + (size_t)s * D + c8 * 8) : (u32x4){0u, 0u, 0u, 0u}; } } while (0)
    PM_LOAD_X(tile);
    for (int tk = 0; tk < tcount && tile < ntile; ++tk, tile += tstep) {
        const int g = tile & 3, tt = tile >> 2, t0 = tt * 64, b = t0 >> 11, s0 = t0 & 2047;
        if (!same_g) PM_LOAD_B(g);
        if (tid < 80) { const int s = s0 - 8 + tid; float inv = 0.f;
            if (s >= 0 && s < SEQ) { const GAS f32x4* sp = (const GAS f32x4*)(ssq_in + (size_t)(b * SEQ + s) * 16); const f32x4 a = sp[0], bq = sp[1], cq = sp[2], dq = sp[3];
                const float tot = ((a[0] + a[1]) + (a[2] + a[3])) + ((bq[0] + bq[1]) + (bq[2] + bq[3])) + ((cq[0] + cq[1]) + (cq[2] + cq[3])) + ((dq[0] + dq[1]) + (dq[2] + dq[3]));
                inv = 1.0f / sqrtf(tot * (1.0f / D) + RMS_EPS); }
            invL[tid] = inv; }
        __syncthreads();
        { const f32x4 ga = *(const GAS f32x4*)(F.norm_mix_g + D + g * 256 + (tid & 31) * 8), gb = *(const GAS f32x4*)(F.norm_mix_g + D + g * 256 + (tid & 31) * 8 + 4);
#pragma unroll
          for (int i = 0; i < 5; ++i) { const int e = tid + i * 512, r = e >> 5, c8 = e & 31; const u32x4 h = xv[i]; const float iv = invL[r];
              *(LAS f32x4*)(hL + r * 256 + c8 * 8) = (f32x4){bf_lo(h.x), bf_hi(h.x), bf_lo(h.y), bf_hi(h.y)} * ga * iv;
              *(LAS f32x4*)(hL + r * 256 + c8 * 8 + 4) = (f32x4){bf_lo(h.z), bf_hi(h.z), bf_lo(h.w), bf_hi(h.w)} * gb * iv; } }
        const int col0 = g * 256 + 32 * wv + 8 * fq;
        if (tk + 1 < tcount && tile + tstep < ntile) PM_LOAD_X(tile + tstep);
        __syncthreads();
        { const int cp = tid & 127, tq = tid >> 7, w = 2 << g, half = w >> 1;
          const LAS f32x2* hp = (const LAS f32x2*)hL + cp;
          const int i0 = tq * 16;
          f32x2 S = (f32x2){0.f, 0.f};
          for (int r = i0 + 8 - half; r < i0 + 8 - half + w; ++r) S += hp[r * 128];
#pragma unroll 4
          for (int i = 0; i < 16; ++i) {
              const int tok = i0 + i, t = s0 + tok, r = tok + 8; const int lo = (t - half) < 0 ? 0 : (t - half), hi = (t - half + w) > SEQ ? SEQ : (t - half + w);
              const float rc = __builtin_amdgcn_rcpf((float)(hi - lo));
              const f32x2 h = hp[r * 128];
              const f32x2 pg = S * rc - h;
              *(LAS unsigned*)(pgL + tok * 512 + ((((cp >> 2) ^ (tok & 15))) << 4) + (cp & 3) * 4) = pk2(pg.x, pg.y);
              S += hp[(r - half + w) * 128]; S -= hp[(r - half) * 128];
          } }
        __syncthreads();
        u32x4 hx[4];
#pragma unroll
        for (int m = 0; m < 4; ++m) hx[m] = *(const GAS u32x4*)(F.XBb + (size_t)(b * SEQ + s0 + 16 * m + fr) * D + col0);
        f32x4 acc[4][2];
#pragma unroll
        for (int m = 0; m < 4; ++m)
#pragma unroll
            for (int nt = 0; nt < 2; ++nt) acc[m][nt] = (f32x4){0.f, 0.f, 0.f, 0.f};
#pragma unroll
        for (int ks = 0; ks < 8; ++ks) {
#pragma unroll
            for (int m = 0; m < 4; ++m) { const bf16x8 Af = *(const LAS bf16x8*)(pgL + (16 * m + fr) * 512 + (((4 * ks + fq) ^ fr) << 4));
#pragma unroll
                for (int nt = 0; nt < 2; ++nt) acc[m][nt] = __builtin_amdgcn_mfma_f32_16x16x32_bf16(Bf[nt][ks], Af, acc[m][nt], 0, 0, 0); }
            if (ks & 1) __builtin_amdgcn_sched_barrier(0);
        }
        { const f32x4 sc0 = *(const GAS f32x4*)(F.pool_scale + col0), sc1 = *(const GAS f32x4*)(F.pool_scale + col0 + 4);
#pragma unroll
          for (int m = 0; m < 4; ++m) { const int tok = 16 * m + fr; const size_t off = (size_t)(b * SEQ + s0 + tok) * D + col0; const u32x4 h = hx[m];
              const f32x4 o0 = (f32x4){bf_lo(h.x), bf_hi(h.x), bf_lo(h.y), bf_hi(h.y)} + sc0 * acc[m][0], o1 = (f32x4){bf_lo(h.z), bf_hi(h.z), bf_lo(h.w), bf_hi(h.w)} + sc1 * acc[m][1];
              *(GAS u32x4*)(F.XBa + off) = pg8::pack8(o0, o1);
              float sq = (o0[0] * o0[0] + o0[1] * o0[1]) + (o0[2] * o0[2] + o0[3] * o0[3]) + (o1[0] * o1[0] + o1[1] * o1[1]) + (o1[2] * o1[2] + o1[3] * o1[3]);
              sq += __shfl_xor(sq, 16); sq += __shfl_xor(sq, 32);
              if (fq == 0) partL[wv * 64 + tok] = sq; } }
        __syncthreads();
        if (tid < 256) { const int r = tid >> 2, q = tid & 3; ssq_out[(size_t)(b * SEQ + s0 + r) * 16 + g * 4 + q] = partL[(2 * q) * 64 + r] + partL[(2 * q + 1) * 64 + r]; }
    }
#undef PM_LOAD_B
#undef PM_LOAD_X
    __syncthreads();
}

struct Args { const float* in[16]; float* out; unsigned char* ws; int ph_lo, ph_hi; };
__global__ void __launch_bounds__(NWAVES * 64, 2) fwd_mega(Args args) {
    extern __shared__ __attribute__((aligned(16))) unsigned char lds[];
    Frame F;
    F.lds = (LAS unsigned char*)lds;
    F.MISC = (volatile LAS unsigned*)(F.lds + MISC_OFF);
    F.tid = threadIdx.x; F.lane = F.tid & 63; F.wave = __builtin_amdgcn_readfirstlane(F.tid >> 6);
    F.G = gridDim.x; { const int bx = blockIdx.x; F.vcu = (F.G % 8 == 0) ? (bx % 8) * (F.G / 8) + bx / 8 : bx; }
    unsigned char* ws = args.ws;
    F.ctl = (gu32*)(ws + WS_CTL);
    F.x = args.in[0]; F.norm_mix_g = args.in[1]; F.norm_ffn_g = args.in[2]; F.w_in = args.in[3]; F.fnet_map = args.in[4]; F.conv_w = args.in[5]; F.conv_b = args.in[6];
    F.ln_g = args.in[7]; F.ln_b = args.in[8]; F.w_out = args.in[9]; F.pool_map = args.in[10]; F.pool_scale = args.in[11]; F.w_gate = args.in[12]; F.w_up = args.in[13]; F.w_down = args.in[14]; F.final_g = args.in[15];
    F.out = args.out; F.ssq = (float*)(ws + WS_SSQ);
    F.WinT = (bf16_t*)(ws + WS_WIN); F.WoT = (bf16_t*)(ws + WS_WO); F.WguT = (bf16_t*)(ws + WS_WGU); F.WdT = (bf16_t*)(ws + WS_WD); F.PmT = (bf16_t*)(ws + WS_PM); F.DM = (bf16_t*)(ws + WS_DM);
    F.XBa = (bf16_t*)(ws + WS_XBA); F.XBb = (bf16_t*)(ws + WS_XBB); F.AT = (bf16_t*)(ws + WS_AT); F.U = (bf16_t*)(ws + WS_U); F.YQ = (bf16_t*)(ws + WS_YQ); F.HID = (bf16_t*)(ws + WS_HID);
    for (int u = F.tid; u < (STASH_OFF - LDSCTL_OFF) / 4; u += NWAVES * 64) ((LAS unsigned*)(F.lds + LDSCTL_OFF))[u] = 0u;
    __syncthreads();
    XcdBarrier bar; bar.bar = (unsigned*)(F.ctl + CW_BAR); bar.x = 0; bar.st = nullptr;
#if !MK_SPLIT
    bar = xcd_barrier_post((unsigned*)(F.ctl + CW_BAR), F.MISC + 8);
#endif
    const int lo = args.ph_lo, hi = args.ph_hi;
#define IN(k) (lo <= (k) && (k) < hi)
#if MK_SPLIT
#define SEAM(k) do { } while (0)
#else
#define SEAM(k) do { if (IN(k) && IN((k) + 1)) { if ((k) == 0) xcd_barrier<true>(bar); else if (MODE_LOC && ((k) == 1 || (k) == 3 || (k) == 4 || (k) == 5 || (k) == 7 || (k) == 8)) grp_barrier((unsigned*)F.ctl, LG, (unsigned)(F.G >> 3), F.MISC + 12); else xcd_barrier<false>(bar); } } while (0)
#endif
    const int bx = (int)blockIdx.x;
    const bool MODE_LOC = (F.G == 256); const unsigned LG = (unsigned)bx & 7u; const int LJ = bx >> 3;
#if !MK_SPLIT
    if (F.tid == 0) __hip_atomic_store((unsigned*)(F.ctl + CW_XID) + bx, 1u + xb_xcc_id(), __ATOMIC_RELAXED, __HIP_MEMORY_SCOPE_AGENT);
#endif
#define STAMP(k) do { if (DIAG_PH >= 0 && blockIdx.x == 0 && F.tid == 0) F.MISC[16 + (k)] = (unsigned)__builtin_amdgcn_s_memrealtime(); } while (0)
    STAMP(0);

#define REPS(k) ((PROBE_PH == (k)) ? (1 + PROBE_REP) : 1)
#define FOR_REP(k) _Pragma("unroll") for (int rep = 0, nrep = REPS(k); rep < nrep; ++rep)
#define DRY (rep + 1 < nrep)
    FOR_REP(0) { if (IN(0)) { p0_prologue(F); } SEAM(0); } STAMP(1);
#if !MK_SPLIT
    if (MODE_LOC && F.tid == 0) { const unsigned mine = 1u + xb_xcc_id(); unsigned same = 1u;
        for (int j = 0; j < 32; ++j) same &= (__hip_atomic_load((unsigned*)(F.ctl + CW_XID) + (int)LG + 8 * j, __ATOMIC_RELAXED, __HIP_MEMORY_SCOPE_AGENT) == mine) ? 1u : 0u;
        F.MISC[12] = same; }
#endif
    FOR_REP(1) {
        if (IN(1)) {
            pg8::ProbIn p; p.init(64, 6, F.G, bx); p.K = 1024; p.lda = 1024; p.ldb = 1024; p.kmult = (PROBE_KMULT_PH == 1) ? PROBE_KMULT : 1; p.X = F.XBa; p.XF = F.XBb; p.WinT = F.WinT; p.AT = F.AT; p.U = F.U;
            pg8::gemm_phase<pg8::ProbIn, true>(F.lds, p);
            { int j, n; const bool idle = idle_slot(F, 384, j, n);
              if (idle) weight_items(F, WI_IN + WI_WO + j * NWAVES + F.wave, WI_IN + WI_WO + WI_LT, n * NWAVES);
              if (F.G == 256) { }
              else if (idle && n == F.G) { for (int it = j; it < 128; it += n) p0_fold_item(F, it); }
              else if (!idle) { const int nbusy = 384 - ((384 + F.G - 1) / F.G - 1) * F.G; for (int it = bx; it < 128; it += nbusy) p0_fold_item(F, it); } }
        }
        SEAM(1); } STAMP(2);
    FOR_REP(2) {
        if (IN(2)) {
            pg8::ProbDft p; p.init(16, 16, F.G, bx); p.K = 1024; p.lda = 1024; p.ldb = 1024; p.DM = F.DM; p.AT = F.AT; p.YQ = F.YQ; p.loc = MODE_LOC; p.lg = (int)LG; p.lj = LJ; p.mult = PROBE_DFT_MULT; p.kmult = (PROBE_KMULT_PH == 2) ? PROBE_KMULT : 1;
            pg8::gemm_phase<pg8::ProbDft, true>(F.lds, p);
            if (MODE_LOC) conv_tile(F, (int)LG * 32 + LJ);
            else for (int t = F.vcu; t < PROBE_CONV_MULT * (MTOK / 64); t += F.G) conv_tile(F, t % (MTOK / 64));
        }
        SEAM(2); } STAMP(3);
    FOR_REP(3) {
        if (IN(3)) {
            pg8::ProbRes<false, false, true> p; p.init(64, 4, F.G, bx); p.kmult = (PROBE_KMULT_PH == 3) ? PROBE_KMULT : 1; p.K = KOUT; p.lda = KOUT; p.ldb = KOUT; p.A = F.YQ; p.Bt = F.WoT; p.a_bs = BBS; p.a_pm = (size_t)256 * KOUT; p.a_pn = 0; p.b_pn = (size_t)256 * KOUT;
            p.base = F.x; p.out = F.XBb; p.scale = nullptr; p.ssq = F.ssq;
            pg8::gemm_phase<pg8::ProbRes<false, false, true>, true>(F.lds, p);
        }
        SEAM(3); } STAMP(4);
#pragma unroll
    for (int l = 0; l < 2; ++l) {
        const int pb = l ? 7 : 4;
        FOR_REP(pb) {
            if (IN(pb)) {
                pg8::ProbGlu p; p.init(64, 22, F.G, bx); p.kmult = (PROBE_KMULT_PH == pb) ? PROBE_KMULT : 1; p.K = 1024; p.lda = 1024; p.ldb = 1024; p.A = l ? F.XBa : F.XBb; p.Bt = F.WguT + (size_t)l * 5632 * 1024; p.ssq = F.ssq + (size_t)(2 * l) * MTOK * 16; p.H = F.HID;
                const bool hm = MODE_LOC && l == 1;
                if (hm) p.nwg = 1280;
                pg8::gemm_phase<pg8::ProbGlu, true>(F.lds, p);
                if (hm) { pg8::ProbGluH q; q.init(64, 22, F.G, bx); q.K = 1024; q.lda = 1024; q.ldb = 1024; q.A = p.A; q.Bt = p.Bt; q.ssq = p.ssq; q.H = p.H;
                          pg8::gemm_phase<pg8::ProbGluH, true, true>(F.lds, q); }
                if (l == 0) { int j, n; if (idle_slot(F, 64 * 22, j, n)) weight_items(F, WI_N0 + j * NWAVES + F.wave, WI_N0 + WI_LT, n * NWAVES); }
            }
            SEAM(pb); } STAMP(pb + 1);
        FOR_REP(pb + 1) {
            if (IN(pb + 1)) {
                if (l == 0) {
                    pg8::ProbRes<false, true, true> p; p.init(64, 4, F.G, bx); p.kmult = (PROBE_KMULT_PH == pb + 1) ? PROBE_KMULT : 1; p.K = DFF; p.lda = DFF; p.ldb = DFF; p.A = F.HID; p.Bt = F.WdT; p.a_bs = BBS; p.a_pm = (size_t)256 * DFF; p.a_pn = 0; p.b_pn = (size_t)256 * DFF;
                    p.base = F.XBb; p.out = DRY ? (void*)(ws + WS_END) : (void*)F.XBb; p.scale = nullptr; p.ssq = DRY ? (float*)(ws + WS_END + 32 * MiB) : F.ssq + (size_t)1 * MTOK * 16;
                    pg8::gemm_phase<pg8::ProbRes<false, true, true>, true>(F.lds, p);
                } else {
                    pg8::ProbRes<false, true, true> p; p.init(64, 4, F.G, bx); p.kmult = (PROBE_KMULT_PH == pb + 1) ? PROBE_KMULT : 1; p.K = DFF; p.lda = DFF; p.ldb = DFF; p.A = F.HID; p.Bt = F.WdT + (size_t)1024 * DFF; p.a_bs = BBS; p.a_pm = (size_t)256 * DFF; p.a_pn = 0; p.b_pn = (size_t)256 * DFF;
                    p.base = F.XBa; p.out = DRY ? (void*)(ws + WS_END) : (void*)F.XBa; p.scale = nullptr; p.ssq = DRY ? (float*)(ws + WS_END + 32 * MiB) : F.ssq + (size_t)3 * MTOK * 16;
                    pg8::gemm_phase<pg8::ProbRes<false, true, true>, true>(F.lds, p);
                }
            }
            SEAM(pb + 1); } STAMP(pb + 2);
        if (l == 0) {
            FOR_REP(6) { if (IN(6)) { if (MODE_LOC) poolmix_phase(F, F.ssq + (size_t)1 * MTOK * 16, F.ssq + (size_t)2 * MTOK * 16, 4 * (32 * (int)LG + (LJ >> 2)) + (LJ & 3), 32, 4);
                else poolmix_phase(F, F.ssq + (size_t)1 * MTOK * 16, F.ssq + (size_t)2 * MTOK * 16, F.vcu, F.G, 4 * (MTOK / 64)); } SEAM(6); } STAMP(7);
        }
    }
    FOR_REP(9) {
        if (IN(9)) {
            const float* ssq = F.ssq + (size_t)3 * MTOK * 16;
            float* dst = DRY ? (float*)(ws + WS_XBA) : F.out;
            const int gw = MODE_LOC ? LJ * NWAVES + F.wave : F.vcu * NWAVES + F.wave, NGW = MODE_LOC ? 256 : F.G * NWAVES, mlo = MODE_LOC ? (int)LG * SEQ : 0, mhi = MODE_LOC ? mlo + SEQ : MTOK;
            float dA = 0.f;
            if (DIAG_PH >= 0 && blockIdx.x == 0) { __syncthreads(); dA = (float)(F.MISC[16 + DIAG_PH + 1] - F.MISC[16 + DIAG_PH]) * 0.01f * DIAG_SCALE; }
            for (int m = mlo + gw; m < mhi; m += 2 * NGW) {
                const int m1 = (m + NGW < mhi) ? m + NGW : m;
                const GAS u32x4* xr0 = (const GAS u32x4*)(F.XBa + (size_t)m * D) + F.lane;
                const GAS u32x4* xr1 = (const GAS u32x4*)(F.XBa + (size_t)m1 * D) + F.lane;
                const float* gr = F.final_g + 8 * F.lane;
                u32x4 h0[2], h1[2]; f32x4 g[2][2];
#pragma unroll
                for (int j = 0; j < 2; ++j) { h0[j] = xr0[64 * j]; h1[j] = xr1[64 * j]; g[j][0] = *(const GAS f32x4*)(gr + 512 * j); g[j][1] = *(const GAS f32x4*)(gr + 512 * j + 4); }
                const float pv0 = (F.lane < 16) ? ssq[(size_t)m * 16 + F.lane] : 0.f, pv1 = (F.lane < 16) ? ssq[(size_t)m1 * 16 + F.lane] : 0.f;
                const float inv0 = 1.0f / sqrtf(wave_sum(pv0) * (1.0f / D) + RMS_EPS), inv1 = 1.0f / sqrtf(wave_sum(pv1) * (1.0f / D) + RMS_EPS);
                float* y0 = dst + (size_t)m * D + 8 * F.lane; float* y1 = dst + (size_t)m1 * D + 8 * F.lane;
#pragma unroll
                for (int j = 0; j < 2; ++j) {
                    f32x4 o0 = (f32x4){bf_lo(h0[j].x), bf_hi(h0[j].x), bf_lo(h0[j].y), bf_hi(h0[j].y)} * inv0 * g[j][0]; const f32x4 o1 = (f32x4){bf_lo(h0[j].z), bf_hi(h0[j].z), bf_lo(h0[j].w), bf_hi(h0[j].w)} * inv0 * g[j][1];
                    if (DIAG_PH >= 0 && m == 0 && F.lane == 0 && j == 0) o0.x += dA;
                    *(GAS f32x4*)(y0 + 512 * j) = o0; *(GAS f32x4*)(y0 + 512 * j + 4) = o1;
                    if (m1 != m) { *(GAS f32x4*)(y1 + 512 * j) = (f32x4){bf_lo(h1[j].x), bf_hi(h1[j].x), bf_lo(h1[j].y), bf_hi(h1[j].y)} * inv1 * g[j][0];
                                   *(GAS f32x4*)(y1 + 512 * j + 4) = (f32x4){bf_lo(h1[j].z), bf_hi(h1[j].z), bf_lo(h1[j].w), bf_hi(h1[j].w)} * inv1 * g[j][1]; } }
            }
        }
        if (DRY) { if (IN(9)) xcd_barrier<false>(bar); } }
#undef REPS
#undef FOR_REP
#undef DRY
#undef IN
#undef SEAM
}

extern "C" void kernel_launch(void* const* d_in, const int* in_sizes, int n_in, void* d_out, int out_size, void* d_ws, size_t ws_size, hipStream_t stream) {
    static int grid = 0;
    if (grid == 0) {
        if (n_in != 16 || in_sizes[0] != MTOK * D || out_size != MTOK * D || ws_size < WS_END) { fprintf(stderr, "kernel_launch: unexpected shapes (n_in %d, in0 %d, out %d, ws %zu)\n", n_in, n_in > 0 ? in_sizes[0] : -1, out_size, ws_size); grid = -1; return; }
        int dev = 0, cus = 0, per_cu = 0;
        if (hipGetDevice(&dev) != hipSuccess || hipDeviceGetAttribute(&cus, hipDeviceAttributeMultiprocessorCount, dev) != hipSuccess) { grid = -1; return; }
        if (hipFuncSetAttribute((const void*)fwd_mega, hipFuncAttributeMaxDynamicSharedMemorySize, LDS_BYTES) != hipSuccess) { fprintf(stderr, "kernel_launch: hipFuncSetAttribute failed\n"); grid = -1; return; }
        if (hipOccupancyMaxActiveBlocksPerMultiprocessor(&per_cu, (const void*)fwd_mega, NWAVES * 64, LDS_BYTES) != hipSuccess || per_cu < 1) { fprintf(stderr, "kernel_launch: occupancy query says %d blocks/CU\n", per_cu); per_cu = 1; }
        (void)hipGetLastError();
        grid = cus;
    }
    if (grid < 0) return;
    if (hipMemsetAsync((char*)d_ws + WS_CTL, 0, CTL_ZERO_BYTES, stream) != hipSuccess) { fprintf(stderr, "kernel_launch: memset failed\n"); return; }
    Args a{};
    for (int i = 0; i < 16; ++i) a.in[i] = (const float*)d_in[i];
    a.out = (float*)d_out; a.ws = (unsigned char*)d_ws;
#if MK_SPLIT
    for (int ph = 0; ph < N_PHASES; ++ph) { a.ph_lo = ph; a.ph_hi = ph + 1; hipLaunchKernelGGL(fwd_mega, dim3(grid), dim3(NWAVES * 64), LDS_BYTES, stream, a); }
#else
    a.ph_lo = 0; a.ph_hi = N_PHASES;
    hipLaunchKernelGGL(fwd_mega, dim3(grid), dim3(NWAVES * 64), LDS_BYTES, stream, a);
#endif
    const hipError_t le = hipPeekAtLastError();
    if (le != hipSuccess) fprintf(stderr, "kernel_launch: launch failed: %s\n", hipGetErrorName(le));
}
```

```cpp
#include <hip/hip_runtime.h>
#include <cstdio>
#include <cstdint>

#ifndef MK_SPLIT
#define MK_SPLIT 0
#endif

#ifndef PROBE_PH
#define PROBE_PH (-1)
#define PROBE_REP 0
#endif
#ifndef DIAG_PH
#define DIAG_PH (-1)
#define DIAG_SCALE 0.01f
#endif
#ifndef PROBE_EPI2
#define PROBE_EPI2 0
#endif
#ifndef PROBE_KMULT
#define PROBE_KMULT 1
#define PROBE_KMULT_PH (-1)
#endif
#ifndef PROBE_CONV_MULT
#define PROBE_CONV_MULT 1
#define PROBE_DFT_MULT 1
#endif
#define LAS __attribute__((address_space(3)))
#define GAS __attribute__((address_space(1)))
typedef unsigned short bf16_t;
typedef short bf16x8 __attribute__((ext_vector_type(8)));
typedef float f32x4 __attribute__((ext_vector_type(4)));
typedef float f32x2 __attribute__((ext_vector_type(2)));
typedef unsigned u32x4 __attribute__((ext_vector_type(4)));
typedef unsigned u32x2 __attribute__((ext_vector_type(2)));
typedef GAS unsigned gu32;

constexpr int BATCH = 8, SEQ = 2048, D = 1024, MTOK = BATCH * SEQ;
constexpr int INAB = 1536, DFF = 2816, KOUT = 1536;
constexpr float RMS_EPS = 1e-6f, LN_EPS = 1e-5f;
constexpr int NWAVES = 8;
constexpr int N_PHASES = 10;

constexpr size_t MiB = 1u << 20;
constexpr size_t WS_CTL = 0, CTL_ZERO_BYTES = 40960;
constexpr size_t WS_SSQ = 1 * MiB;
constexpr size_t WS_WIN = 5 * MiB;
constexpr size_t WS_WO = 8 * MiB;
constexpr size_t WS_WGU = 11 * MiB;
constexpr size_t WS_WD = 33 * MiB;
constexpr size_t WS_PM = 44 * MiB;
constexpr size_t WS_DM = 45 * MiB;
constexpr size_t WS_XBA = 61 * MiB;
constexpr size_t WS_XBB = 93 * MiB;
constexpr size_t WS_BB = 125 * MiB;
constexpr size_t BBS = 11 * MiB / 2;
constexpr size_t WS_AT = WS_BB;
constexpr size_t WS_U = WS_BB + 2 * MiB;
constexpr size_t WS_YQ = WS_BB + 4 * MiB;
constexpr size_t WS_HID = WS_BB;
constexpr size_t WS_END = 213 * MiB;
constexpr int CW_BAR = 4096;
constexpr int CW_XID = 8960;
constexpr int CW_GRP = 7680;

constexpr int RING_BYTES = 131072;
constexpr int LDSCTL_OFF = RING_BYTES, MISC_OFF = LDSCTL_OFF + 320;
constexpr int STASH_OFF = LDSCTL_OFF + 1024;
constexpr int INVTAB_OFF = STASH_OFF + 16384;
constexpr int LDS_BYTES = INVTAB_OFF + 1024;

#define LDS_WAIT() asm volatile("s_waitcnt lgkmcnt(0)" ::: "memory")
#define VM_WAIT() asm volatile("s_waitcnt vmcnt(0)" ::: "memory")
__device__ __forceinline__ unsigned f2bf(float f) { unsigned u = __builtin_bit_cast(unsigned, f); return (u + 0x7fffu + ((u >> 16) & 1u)) >> 16; }
__device__ __forceinline__ unsigned pk2(float lo, float hi) { return f2bf(lo) | (f2bf(hi) << 16); }
__device__ __forceinline__ unsigned cvt_pk_bf16(float lo, float hi) { unsigned r; asm volatile("v_cvt_pk_bf16_f32 %0, %1, %2" : "=v"(r) : "v"(lo), "v"(hi)); return r; }
__device__ __forceinline__ float bf_lo(unsigned w) { return __builtin_bit_cast(float, w << 16); }
__device__ __forceinline__ float bf_hi(unsigned w) { return __builtin_bit_cast(float, w & 0xffff0000u); }
__device__ __forceinline__ float wave_sum(float v) {
    v += __builtin_bit_cast(float, __builtin_amdgcn_update_dpp(0, __builtin_bit_cast(int, v), 0xB1, 0xf, 0xf, true));
    v += __builtin_bit_cast(float, __builtin_amdgcn_update_dpp(0, __builtin_bit_cast(int, v), 0x4E, 0xf, 0xf, true));
    v += __builtin_bit_cast(float, __builtin_amdgcn_update_dpp(0, __builtin_bit_cast(int, v), 0x141, 0xf, 0xf, true));
    v += __builtin_bit_cast(float, __builtin_amdgcn_update_dpp(0, __builtin_bit_cast(int, v), 0x140, 0xf, 0xf, true));
    { float a = v, b = v; asm("s_nop 1\n\tv_permlane16_swap_b32 %0, %1\n\ts_nop 1" : "+v"(a), "+v"(b)); v = a + b; }
    { float a = v, b = v; asm("s_nop 1\n\tv_permlane32_swap_b32 %0, %1\n\ts_nop 1" : "+v"(a), "+v"(b)); v = a + b; }
    return v;
}
__device__ __forceinline__ float fast_sigmoid(float g) { return __builtin_amdgcn_rcpf(1.0f + __builtin_amdgcn_exp2f(g * -1.44269504089f)); }

#define XB_TMO      128
#define XB_XCNT(j)  (256  + 64 * (j))
#define XB_XSUB(j)  (1280 + 64 * (j))
#define XB_XGEN(j)  (2304 + 64 * (j))
#define XB_TOP      3328
#define XB_TOPGEN   3392
#define XCD_BAR_WORDS 3456
#define XB_SPIN_CAP (1u << 18)
__device__ __forceinline__ unsigned xb_ld(unsigned* p)              { return __hip_atomic_load(p, __ATOMIC_RELAXED, __HIP_MEMORY_SCOPE_AGENT); }
__device__ __forceinline__ unsigned xb_add(unsigned* p, unsigned v) { return __hip_atomic_fetch_add(p, v, __ATOMIC_RELAXED, __HIP_MEMORY_SCOPE_AGENT); }
__device__ __forceinline__ unsigned xb_xcc_id() { return (unsigned)__builtin_amdgcn_s_getreg((3 << 11) | 20) & 0xFu; }
#define XB_SPIN(cond, bar) do { unsigned _sp = 0; while (cond) { __builtin_amdgcn_s_sleep(1); \
    if ((++_sp & 255u) == 0u) { if (xb_ld(&(bar)[XB_TMO])) break; if (_sp > XB_SPIN_CAP) { atomicAdd(&(bar)[XB_TMO], 1u); break; } } } } while (0)
struct XcdBarrier { unsigned* bar; unsigned x; volatile LAS unsigned* st; };
__device__ __forceinline__ XcdBarrier xcd_barrier_post(unsigned* bar, volatile LAS unsigned* st) {
    XcdBarrier b; b.bar = bar; b.x = xb_xcc_id(); b.st = st;
    if (threadIdx.x == 0) (void)xb_add(&bar[XB_XCNT(b.x)], 1u);
    return b;
}
__device__ __forceinline__ void xcd_barrier_complete(unsigned* bar, unsigned x, unsigned& nloc, unsigned& nx) {
    const unsigned G = gridDim.x * gridDim.y * gridDim.z;
    unsigned sum, cnt, mine, sp = 0u;
    for (;;) {
        sum = 0u; cnt = 0u; mine = 0u;
#pragma unroll
        for (unsigned j = 0; j < 16; ++j) { const unsigned c = xb_ld(&bar[XB_XCNT(j)]); sum += c; cnt += (c > 0u) ? 1u : 0u; mine = (j == x) ? c : mine; }
        if (sum == G) break;
        __builtin_amdgcn_s_sleep(1);
        if ((++sp & 255u) == 0u) { if (xb_ld(&bar[XB_TMO])) break; if (sp > XB_SPIN_CAP) { atomicAdd(&bar[XB_TMO], 1u); break; } }
    }
    nloc = mine > 0u ? mine : 1u; nx = cnt > 0u ? cnt : 1u;
}
template <bool FIRST>
__device__ __forceinline__ void xcd_barrier(const XcdBarrier& b) {
    asm volatile("s_waitcnt vmcnt(0)" ::: "memory");
    __syncthreads();
    if (threadIdx.x == 0) {
        unsigned* bar = b.bar;
        __builtin_amdgcn_s_waitcnt(0);
        unsigned nloc = b.st[0], nx = b.st[1];
        if (FIRST) { xcd_barrier_complete(bar, b.x, nloc, nx); b.st[0] = nloc; b.st[1] = nx; }
        const unsigned old = xb_add(&bar[XB_XSUB(b.x)], 1u);
        const unsigned gen = old / nloc;
        if (old + 1u == (gen + 1u) * nloc) {
            __builtin_amdgcn_fence(__ATOMIC_RELEASE, "agent");
            asm volatile("s_waitcnt vmcnt(0)" ::: "memory");
            const unsigned og = xb_add(&bar[XB_TOP], 1u);
            const unsigned tg = og / nx;
            if (og + 1u == (tg + 1u) * nx) xb_add(&bar[XB_TOPGEN], 1u);
            else XB_SPIN(xb_ld(&bar[XB_TOPGEN]) == tg, bar);
            __builtin_amdgcn_fence(__ATOMIC_ACQUIRE, "agent");
            xb_add(&bar[XB_XGEN(b.x)], 1u);
            asm volatile("s_waitcnt vmcnt(0)" ::: "memory");
        } else {
            XB_SPIN(xb_ld(&bar[XB_XGEN(b.x)]) == gen, bar);
            __builtin_amdgcn_fence(__ATOMIC_ACQUIRE, "agent");
            asm volatile("s_waitcnt vmcnt(0)" ::: "memory");
        }
    }
    __syncthreads();
}

__device__ __forceinline__ void grp_barrier(unsigned* ctl, unsigned g, unsigned n, volatile LAS unsigned* coloc) {
    asm volatile("s_waitcnt vmcnt(0)" ::: "memory");
    __syncthreads();
    if (threadIdx.x == 0) {
        unsigned* cnt = ctl + CW_GRP + 64 * g; unsigned* gen = ctl + CW_GRP + 64 * (8 + g);
        __builtin_amdgcn_s_waitcnt(0);
        if (coloc[0] == 0u) {
            __builtin_amdgcn_fence(__ATOMIC_RELEASE, "agent");
            asm volatile("s_waitcnt vmcnt(0)" ::: "memory"); }
        const unsigned old = xb_add(cnt, 1u), ge = old / n;
        if (old + 1u == (ge + 1u) * n) xb_add(gen, 1u);
        else { unsigned sp = 0; while (xb_ld(gen) == ge) { __builtin_amdgcn_s_sleep(1); if (++sp > (1u << 20)) break; } }
        __builtin_amdgcn_fence(__ATOMIC_ACQUIRE, "agent");
        asm volatile("s_waitcnt vmcnt(0)" ::: "memory");
    }
    __syncthreads();
}

namespace pg8 {
constexpr int BM = 256, BK = 64, HALF = 128, HTB = HALF * BK * 2, STAGE_BYTES = 8 * HTB, NXCD = 8, WGM = 8;
__host__ __device__ __forceinline__ int lds_byte(int r, int c) { const int st = (r >> 4) * 2 + (c >> 5), rr = r & 15, cc = c & 31, ob = rr * 64 + cc * 2; return st * 1024 + (ob ^ (((ob >> 9) & 1) << 5)); }
__host__ __device__ __forceinline__ void stage_rc(int b, int& R, int& C) { const int st = b / 1024, sb = b % 1024, swz = sb ^ (((sb >> 9) & 1) << 5); R = (st >> 1) * 16 + swz / 64; C = (st & 1) * 32 + (swz % 64) / 2; }
__host__ __device__ __forceinline__ int perm32(int rho) { const int n = rho >> 4, i = rho & 15; return 8 * (i >> 2) + 4 * n + (i & 3); }
struct Unit { int pm, pn; };
struct Order {
    int nM, nN, nwg, G, c, mult = 1, kmult = 1; bool epi2 = false;
    __device__ __forceinline__ void init(int nM_, int nN_, int G_, int c_) { nM = nM_; nN = nN_; nwg = nM * nN; G = G_; c = c_; }
    __device__ __forceinline__ bool next(int i, Unit& u) const {
        const long L = (long)i * G + c; if (L >= (long)nwg * mult) return false;
        if (nM == 64 && (G & 7) == 0 && mult == 1) {
            const int w = (int)L >> 3; u.pm = 8 * ((int)L & 7) + (w & 7); u.pn = w >> 3; return true; }
        int wgid = (int)(L % nwg); { const int q = nwg / NXCD, r = nwg % NXCD, xcd = wgid % NXCD, off = wgid / NXCD; wgid = (xcd < r ? xcd * (q + 1) : r * (q + 1) + (xcd - r) * q) + off; }
        const int nig = WGM * nN, gid = wgid / nig, fm = gid * WGM, gsz = (nM - fm) < WGM ? (nM - fm) : WGM;
        u.pm = fm + ((wgid % nig) % gsz); u.pn = (wgid % nig) / gsz; return true;
    }
};
template <class P, bool ALIGN_EPI, bool HM = false>
__device__ __forceinline__ void gemm_phase(LAS unsigned char* lds, const P& p) {
    int tid = threadIdx.x; asm volatile("" : "+v"(tid));
    const int wid = __builtin_amdgcn_readfirstlane(tid >> 6), lane = tid & 63, wr = wid >> 2, wc = wid & 3, fr = lane & 15, fq = lane >> 4;
    const int K = p.K, nt = K / BK;
    unsigned voffA[2], voffB[2];
#pragma unroll
    for (int i = 0; i < 2; ++i) { int R, C; stage_rc(tid * 16 + i * 8192, R, C); const int Rb = P::PERM ? ((R & ~31) + perm32(R & 31)) : R;
        voffA[i] = (unsigned)(R * p.lda + C) * 2u; voffB[i] = (unsigned)(Rb * p.ldb + C) * 2u; }
    const size_t kstep = (size_t)(BK * 2);
    const size_t hstepA = (size_t)HALF * p.lda * 2, hstepB = (size_t)HALF * p.ldb * 2;
    const unsigned ldsw = (unsigned)wid * 1024u;
    const int aoff = lds_byte(wr * 64 + fr, fq * 8), boff = lds_byte(wc * 32 + fr, fq * 8);
#define PG8_SA(b, h) (((b) * 2 + (h)) * HTB)
#define PG8_SB(b, h) ((4 + (b) * 2 + (h)) * HTB)
#define PG8_STAGE(bufoff, gbase, voff) do { _Pragma("unroll") for (int _i = 0; _i < 2; ++_i) \
        __builtin_amdgcn_global_load_lds((const unsigned*)((const char*)(gbase) + (voff)[_i]), (LAS unsigned*)(lds + (bufoff) + ldsw + _i * 8192), 16, 0, 0); } while (0)
#define PG8_LDA(dst, b, h) do { _Pragma("unroll") for (int m = 0; m < 4; ++m) _Pragma("unroll") for (int k = 0; k < 2; ++k) dst[m][k] = *(const LAS bf16x8*)(lds + PG8_SA(b, h) + aoff + m * 2048 + k * 1024); } while (0)
#define PG8_LDB(dst, b, h) do { _Pragma("unroll") for (int n = 0; n < 2; ++n) _Pragma("unroll") for (int k = 0; k < 2; ++k) dst[n][k] = *(const LAS bf16x8*)(lds + PG8_SB(b, h) + boff + n * 2048 + k * 1024); } while (0)
#define PG8_MMA(ai, bj, At, Bt) do { __builtin_amdgcn_s_setprio(1); _Pragma("unroll") for (int m = 0; m < 4; ++m) _Pragma("unroll") for (int n = 0; n < 2; ++n) _Pragma("unroll") for (int k = 0; k < 2; ++k) \
        acc[ai][bj][m][n] = __builtin_amdgcn_mfma_f32_16x16x32_bf16(Bt[n][k], At[m][k], acc[ai][bj][m][n], 0, 0, 0); __builtin_amdgcn_s_setprio(0); } while (0)
#define PG8_WAIT_V(n) asm volatile("s_waitcnt vmcnt(" #n ")" ::: "memory")
#define PG8_WAIT_L(n) asm volatile("s_waitcnt lgkmcnt(" #n ")" ::: "memory")
#define PG8_BAR __builtin_amdgcn_s_barrier()
#define PG8_SCHED __builtin_amdgcn_sched_barrier(0)
    Unit cur, nxt; int ui = 0;
    if (!p.next(0, cur)) return;
    f32x4 acc[2][2][4][2];
#pragma unroll
    for (int a = 0; a < 2; ++a)
#pragma unroll
        for (int b = 0; b < 2; ++b)
#pragma unroll
            for (int m = 0; m < 4; ++m)
#pragma unroll
                for (int n = 0; n < 2; ++n) acc[a][b][m][n] = (f32x4){0.f, 0.f, 0.f, 0.f};
    bf16x8 At[4][2], B0[2][2], B1[2][2];
    const char* cA = p.aptr(cur); const char* cB = p.bptr(cur);
    const char* cB1 = cB + hstepB; unsigned vB1[2] = {voffB[0], voffB[1]}, vB1n[2] = {voffB[0], voffB[1]};
    if constexpr (P::SPLITB) { cB1 = p.bptr1(cur); p.voff1(cur, tid, voffB, vB1); }
    PG8_STAGE(PG8_SB(0, 0), cB, voffB); PG8_STAGE(PG8_SB(0, 1), cB1, vB1); PG8_STAGE(PG8_SA(0, 0), cA, voffA); if constexpr (!HM) PG8_STAGE(PG8_SA(0, 1), cA + hstepA, voffA);
    PG8_STAGE(PG8_SB(1, 0), cB + kstep, voffB); PG8_STAGE(PG8_SA(1, 0), cA + kstep, voffA); PG8_STAGE(PG8_SB(1, 1), cB1 + kstep, vB1);
    if (wr == 1) PG8_BAR;
    if constexpr (HM) PG8_WAIT_V(6); else PG8_WAIT_V(8);
    PG8_BAR;
    PG8_BAR;
    for (;;) {
        const bool has_next = p.next(ui + 1, nxt);
        const char* nA = has_next ? p.aptr(nxt) : cA; const char* nB = has_next ? p.bptr(nxt) : cB;
        const char* nB1 = nB + hstepB;
        if constexpr (P::SPLITB) { nB1 = cB1; vB1n[0] = vB1[0]; vB1n[1] = vB1[1]; if (has_next) { nB1 = p.bptr1(nxt); p.voff1(nxt, tid, voffB, vB1n); } }
#if PROBE_KMULT > 1
        for (int tt = 0; tt < nt * p.kmult; tt += 2) {
            const int t = tt % nt; const bool last = (tt == nt * p.kmult - 2);
            const char* a1 = cA + (size_t)(t + 1) * kstep;
            const char* a2 = last ? nA : cA + (size_t)((t + 2) % nt) * kstep; const char* b2 = last ? nB : cB + (size_t)((t + 2) % nt) * kstep;
#else
        for (int t = 0; t < nt; t += 2) {
            const bool last = (t == nt - 2);
            const char* a1 = cA + (size_t)(t + 1) * kstep;
            const char* a2 = last ? nA : cA + (size_t)(t + 2) * kstep; const char* b2 = last ? nB : cB + (size_t)(t + 2) * kstep;
#endif
            const char* a3 = a2 + kstep; const char* b3 = b2 + kstep;
            const char* b2h = last ? nB1 : cB1 + (size_t)(t + 2) * kstep; const char* b3h = b2h + kstep;
            unsigned vh[2] = {voffB[0], voffB[1]};
            if constexpr (P::SPLITB) { vh[0] = last ? vB1n[0] : vB1[0]; vh[1] = last ? vB1n[1] : vB1[1]; }
            if constexpr (P::HAS_PRE) { if (last) p.pre(cur, lds, wid, lane); }
            PG8_LDB(B0, 0, 0); PG8_LDB(B1, 0, 1); PG8_SCHED; PG8_LDA(At, 0, 0); if constexpr (!HM) PG8_STAGE(PG8_SA(1, 1), a1 + hstepA, voffA);
            PG8_WAIT_V(8); PG8_WAIT_L(0); PG8_BAR; PG8_MMA(0, 0, At, B0); PG8_MMA(0, 1, At, B1); PG8_BAR; PG8_SCHED;
            if constexpr (!HM) PG8_LDA(At, 0, 1);
            PG8_STAGE(PG8_SB(0, 0), b2, voffB); PG8_STAGE(PG8_SB(0, 1), b2h, vh); PG8_STAGE(PG8_SA(0, 0), a2, voffA);
            if constexpr (HM) PG8_WAIT_V(6); else PG8_WAIT_V(8);
            PG8_WAIT_L(0); PG8_BAR; if constexpr (!HM) { PG8_MMA(1, 0, At, B0); PG8_MMA(1, 1, At, B1); } PG8_BAR; PG8_SCHED;
            PG8_LDB(B0, 1, 0); PG8_LDB(B1, 1, 1); PG8_SCHED; PG8_LDA(At, 1, 0); if constexpr (!HM) PG8_STAGE(PG8_SA(0, 1), a2 + hstepA, voffA);
            PG8_WAIT_V(8); PG8_WAIT_L(0); PG8_BAR; PG8_MMA(0, 0, At, B0); PG8_MMA(0, 1, At, B1); PG8_BAR; PG8_SCHED;
            if constexpr (!HM) PG8_LDA(At, 1, 1);
            PG8_STAGE(PG8_SB(1, 0), b3, voffB); PG8_STAGE(PG8_SB(1, 1), b3h, vh); PG8_STAGE(PG8_SA(1, 0), a3, voffA);
            if constexpr (HM) PG8_WAIT_V(6); else PG8_WAIT_V(8);
            PG8_WAIT_L(0); PG8_BAR; if constexpr (!HM) { PG8_MMA(1, 0, At, B0); PG8_MMA(1, 1, At, B1); } PG8_BAR; PG8_SCHED;
        }
        if constexpr (ALIGN_EPI) { if (wr == 0) PG8_BAR; }
#if PROBE_KMULT > 1
        if (p.kmult > 1) { const float sc_ = 1.0f / (float)p.kmult;
#pragma unroll
            for (int a = 0; a < 2; ++a)
#pragma unroll
                for (int b = 0; b < 2; ++b)
#pragma unroll
                    for (int m = 0; m < 4; ++m)
#pragma unroll
                        for (int n = 0; n < 2; ++n) acc[a][b][m][n] *= sc_; }
#endif
        p.epi(acc, cur, wr, wc, fr, fq, lds);
        if (PROBE_EPI2 && p.epi2) { asm volatile("" ::: "memory"); p.epi(acc, cur, wr, wc, fr, fq, lds); }
        if (!has_next) break;
#pragma unroll
        for (int a = 0; a < 2; ++a)
#pragma unroll
            for (int b = 0; b < 2; ++b)
#pragma unroll
                for (int m = 0; m < 4; ++m)
#pragma unroll
                    for (int n = 0; n < 2; ++n) acc[a][b][m][n] = (f32x4){0.f, 0.f, 0.f, 0.f};
        cur = nxt; cA = nA; cB = nB; cB1 = nB1; vB1[0] = vB1n[0]; vB1[1] = vB1n[1]; ++ui;
        if constexpr (ALIGN_EPI) { if (wr == 1) PG8_BAR; }
    }
    PG8_WAIT_V(0);
    if constexpr (!ALIGN_EPI) { if (wr == 0) PG8_BAR; }
    PG8_BAR;
#undef PG8_SA
#undef PG8_SB
#undef PG8_STAGE
#undef PG8_LDA
#undef PG8_LDB
#undef PG8_MMA
#undef PG8_WAIT_V
#undef PG8_WAIT_L
#undef PG8_BAR
#undef PG8_SCHED
}

__device__ __forceinline__ u32x4 pack8(const f32x4 v0, const f32x4 v1) {
    u32x4 w; w.x = cvt_pk_bf16(v0[0], v0[1]); w.y = cvt_pk_bf16(v0[2], v0[3]); w.z = cvt_pk_bf16(v1[0], v1[1]); w.w = cvt_pk_bf16(v1[2], v1[3]); return w;
}

struct ProbIn : Order {
    static constexpr bool PERM = true, HAS_PRE = false, SPLITB = true;
    int K, lda, ldb;
    const bf16_t* X; const bf16_t* WinT; bf16_t* AT; bf16_t* U;
    __device__ __forceinline__ const char* aptr(const Unit& u) const { return u.pn >= 4 ? (const char*)(WinT + (size_t)(u.pn - 4) * 256 * 1024) : (const char*)(X + (size_t)u.pm * 256 * 1024); }
    __device__ __forceinline__ const char* bptr(const Unit& u) const { return u.pn >= 4 ? (const char*)(X + ((size_t)(u.pm >> 3) * SEQ + (size_t)(u.pm & 7) * 128) * 1024) : (const char*)(WinT + (size_t)(512 + u.pn * 256) * 1024); }
    __device__ __forceinline__ const char* bptr1(const Unit& u) const {
        if (u.pn < 4) return (const char*)(WinT + (size_t)(512 + u.pn * 256 + 128) * 1024);
        const int b = u.pm >> 3, sb = u.pm & 7;
        return (const char*)(X + ((size_t)b * SEQ + (size_t)(sb ? SEQ - 128 * sb - 127 : SEQ / 2)) * 1024);
    }
    __device__ __forceinline__ void voff1(const Unit& u, int tid, const unsigned (&vn)[2], unsigned (&out)[2]) const {
        const bool fn = u.pn >= 4, sb0 = (u.pm & 7) == 0;
#pragma unroll
        for (int i = 0; i < 2; ++i) { int R, C; stage_rc(tid * 16 + i * 8192, R, C); const int j = (R & ~31) + perm32(R & 31);
            const unsigned vm = sb0 ? (j == 0 ? (unsigned)C * 2u : (unsigned)((SEQ / 2 - j) * 1024 + C) * 2u) : (unsigned)((127 - j) * 1024 + C) * 2u;
            out[i] = fn ? vm : vn[i]; }
    }
    __device__ __forceinline__ void epi(const f32x4 (&acc)[2][2][4][2], const Unit& u, int wr, int wc, int fr, int fq, LAS unsigned char* lds) const {
        if (u.pn >= 4) {
            const int b = u.pm >> 3, sb = u.pm & 7, s0 = sb * 128 + wc * 32 + 8 * fq;
            const bool first = (sb == 0) && (wc == 0) && (fq == 0);
#pragma unroll
            for (int ai = 0; ai < 2; ++ai)
#pragma unroll
                for (int m = 0; m < 4; ++m) { const int np = (u.pn - 4) * 256 + ai * 128 + wr * 64 + m * 16 + fr;
                    const f32x4 a0 = acc[ai][0][m][0], a1 = acc[ai][0][m][1], r0 = acc[ai][1][m][0], r1 = acc[ai][1][m][1];
                    f32x4 sm0 = a0 + r0, df0 = a0 - r0; const f32x4 sm1 = a1 + r1, df1 = a1 - r1;
                    if (first) { sm0[0] = a0[0]; df0[0] = r0[0]; }
                    bf16_t* op = AT + (size_t)b * BBS + (size_t)np * 1024 + s0;
                    *(u32x4*)op = pack8(sm0, sm1); *(u32x4*)(op + (size_t)512 * 1024) = pack8(df0, df1); }
        } else {
            const int ch0 = u.pn * 128 + wc * 32 + 8 * fq;
#pragma unroll
            for (int ai = 0; ai < 2; ++ai)
#pragma unroll
                for (int m = 0; m < 4; ++m) { const int row = u.pm * 256 + ai * 128 + wr * 64 + m * 16 + fr;
                    f32x4 o0, o1;
#pragma unroll
                    for (int j = 0; j < 4; ++j) { o0[j] = acc[ai][0][m][0][j] * fast_sigmoid(acc[ai][1][m][0][j]); o1[j] = acc[ai][0][m][1][j] * fast_sigmoid(acc[ai][1][m][1][j]); }
                    *(u32x4*)(U + (size_t)(row >> 11) * BBS + (size_t)(row & 2047) * 512 + ch0) = pack8(o0, o1); }
        }
    }
};
struct ProbDft : Order {
    static constexpr bool PERM = true, HAS_PRE = false, SPLITB = false;
    int K, lda, ldb;
    const bf16_t* DM; const bf16_t* AT; bf16_t* YQ; bool loc; int lg, lj;
    __device__ __forceinline__ bool next(int i, Unit& u) const { if (!loc) return Order::next(i, u); if (i > 0) return false; u.pm = lj & 15; u.pn = 2 * lg + (lj >> 4); return true; }
    __device__ __forceinline__ const char* aptr(const Unit& u) const { return (const char*)(DM + (size_t)u.pm * 256 * 1024); }
    __device__ __forceinline__ const char* bptr(const Unit& u) const { return (const char*)(AT + (size_t)(u.pn >> 1) * BBS + (size_t)((u.pm >> 3) * 512 + (u.pn & 1) * 256) * 1024); }
    __device__ __forceinline__ void epi(const f32x4 (&acc)[2][2][4][2], const Unit& u, int wr, int wc, int fr, int fq, LAS unsigned char* lds) const {
        const int cs = u.pm >> 3, b = u.pn >> 1, n0 = (u.pn & 1) * 256 + wc * 32 + 8 * fq;
        f32x4 e0[2], e1[2];
#pragma unroll
        for (int bj = 0; bj < 2; ++bj) { e0[bj] = (f32x4){0.f, 0.f, 0.f, 0.f}; e1[bj] = e0[bj]; }
        if (cs == 0) {
            const float sg = (fr & 1) ? -1.0f : 1.0f;
#pragma unroll
            for (int bj = 0; bj < 2; ++bj) { const bf16_t* ap = AT + (size_t)b * BBS + (size_t)(512 + n0 + bj * 128) * 1024;
#pragma unroll
                for (int j = 0; j < 4; ++j) { e0[bj][j] = sg * bf_lo((unsigned)ap[(size_t)j * 1024]); e1[bj][j] = sg * bf_lo((unsigned)ap[(size_t)(4 + j) * 1024]); } }
        }
#pragma unroll
        for (int ai = 0; ai < 2; ++ai)
#pragma unroll
            for (int m = 0; m < 4; ++m) { const int k = (u.pm & 7) * 256 + ai * 128 + wr * 64 + m * 16 + fr;
                bf16_t* rowp = YQ + (size_t)b * BBS + (size_t)k * KOUT + cs * 512 + n0;
#pragma unroll
                for (int bj = 0; bj < 2; ++bj) *(u32x4*)(rowp + bj * 128) = pack8(acc[ai][bj][m][0] + e0[bj], acc[ai][bj][m][1] + e1[bj]); }
    }
};
template <bool SCALE, bool BASEBF, bool OUTBF>
struct ProbRes : Order {
    static constexpr bool PERM = true, HAS_PRE = false, SPLITB = false;
    int K, lda, ldb;
    const bf16_t* A; const bf16_t* Bt; size_t a_bs, a_pm, a_pn, b_pn;
    const void* base; void* out; const float* scale; float* ssq;
    __device__ __forceinline__ const char* aptr(const Unit& u) const { return (const char*)(A + (size_t)(u.pm >> 3) * a_bs + (size_t)(u.pm & 7) * a_pm + (size_t)u.pn * a_pn); }
    __device__ __forceinline__ const char* bptr(const Unit& u) const { return (const char*)(Bt + (size_t)u.pn * b_pn); }
    __device__ __forceinline__ void epi(const f32x4 (&acc)[2][2][4][2], const Unit& u, int wr, int wc, int fr, int fq, LAS unsigned char* lds) const {
        const __amdgpu_buffer_rsrc_t rB = __builtin_amdgcn_make_buffer_rsrc((void*)base, 0, MTOK * D * (BASEBF ? 2 : 4), 0x00020000);
        const __amdgpu_buffer_rsrc_t rO = __builtin_amdgcn_make_buffer_rsrc((void*)out, 0, MTOK * D * (OUTBF ? 2 : 4), 0x00020000);
        const __amdgpu_buffer_rsrc_t rS = __builtin_amdgcn_make_buffer_rsrc((void*)ssq, 0, MTOK * 16 * 4, 0x00020000);
        const int vo = ((wr * 64 + fr) * D + wc * 32 + 8 * fq) * 4;
        const int vs = (wr * 64 + fr) * 64 + wc * 4;
        const int so0 = (u.pm * 256 * D + u.pn * 256) * 4;
        f32x4 sc[2][2];
        if (SCALE) {
            const int col0 = u.pn * 256 + wc * 32 + 8 * fq;
#pragma unroll
            for (int bj = 0; bj < 2; ++bj)
#pragma unroll
                for (int n = 0; n < 2; ++n) sc[bj][n] = *(const f32x4*)(scale + col0 + bj * 128 + 4 * n);
        }
        f32x4 bv[3][2][2]; u32x4 bh[3][2];
#define RES_SO(s, bj) (so0 + ((((s) >> 2) * 128 + ((s) & 3) * 16) * D + (bj) * 128) * 4)
#define RES_LOAD(s) do { _Pragma("unroll") for (int bj = 0; bj < 2; ++bj) { \
            if (BASEBF) bh[(s) % 3][bj] = __builtin_amdgcn_raw_buffer_load_b128(rB, vo >> 1, RES_SO(s, bj) >> 1, 0); \
            else { bv[(s) % 3][bj][0] = __builtin_bit_cast(f32x4, __builtin_amdgcn_raw_buffer_load_b128(rB, vo, RES_SO(s, bj), 0)); \
                   bv[(s) % 3][bj][1] = __builtin_bit_cast(f32x4, __builtin_amdgcn_raw_buffer_load_b128(rB, vo + 16, RES_SO(s, bj), 0)); } } } while (0)
        RES_LOAD(0); RES_LOAD(1);
#pragma unroll
        for (int s = 0; s < 8; ++s) {
            if (s + 2 < 8) RES_LOAD(s + 2);
            asm volatile("" ::: "memory");
            const int ai = s >> 2, m = s & 3;
            float sq = 0.f;
#pragma unroll
            for (int bj = 0; bj < 2; ++bj) {
                f32x4 b0, b1;
                if (BASEBF) { const u32x4 h = bh[s % 3][bj]; b0 = (f32x4){bf_lo(h.x), bf_hi(h.x), bf_lo(h.y), bf_hi(h.y)}; b1 = (f32x4){bf_lo(h.z), bf_hi(h.z), bf_lo(h.w), bf_hi(h.w)}; }
                else { b0 = bv[s % 3][bj][0]; b1 = bv[s % 3][bj][1]; }
                f32x4 o0, o1;
                if (SCALE) { o0 = b0 + acc[ai][bj][m][0] * sc[bj][0]; o1 = b1 + acc[ai][bj][m][1] * sc[bj][1]; }
                else { o0 = b0 + acc[ai][bj][m][0]; o1 = b1 + acc[ai][bj][m][1]; }
                if (OUTBF) *(u32x4*)((bf16_t*)out + (size_t)(u.pm * 256 + ai * 128 + wr * 64 + m * 16 + fr) * D + u.pn * 256 + bj * 128 + wc * 32 + 8 * fq) = pack8(o0, o1);
                else { __builtin_amdgcn_raw_buffer_store_b128(__builtin_bit_cast(u32x4, o0), rO, vo, RES_SO(s, bj), 0);
                       __builtin_amdgcn_raw_buffer_store_b128(__builtin_bit_cast(u32x4, o1), rO, vo + 16, RES_SO(s, bj), 0); }
                sq += (o0[0] * o0[0] + o0[1] * o0[1]) + (o0[2] * o0[2] + o0[3] * o0[3]) + (o1[0] * o1[0] + o1[1] * o1[1]) + (o1[2] * o1[2] + o1[3] * o1[3]);
            }
            sq += __shfl_xor(sq, 16); sq += __shfl_xor(sq, 32);
            if (fq == 0) __builtin_amdgcn_raw_buffer_store_b32(__builtin_bit_cast(unsigned, sq), rS, vs, (u.pm * 256 + ai * 128 + m * 16) * 64 + u.pn * 16, 0);
            asm volatile("" ::: "memory");
        }
#undef RES_LOAD
#undef RES_SO
    }
};
struct ProbGlu : Order {
    static constexpr bool PERM = true, HAS_PRE = true, SPLITB = false;
    int K, lda, ldb;
    const bf16_t* A; const bf16_t* Bt; const float* ssq; bf16_t* H;
    __device__ __forceinline__ const char* aptr(const Unit& u) const { return (const char*)(A + (size_t)u.pm * 256 * 1024); }
    __device__ __forceinline__ const char* bptr(const Unit& u) const { return (const char*)(Bt + (size_t)u.pn * 256 * 1024); }
    __device__ __forceinline__ void pre(const Unit& u, LAS unsigned char* lds, int wid, int lane) const {
        const char* src = (const char*)(ssq + (size_t)u.pm * 256 * 16) + wid * 2048 + lane * 16;
#pragma unroll
        for (int i = 0; i < 2; ++i) __builtin_amdgcn_global_load_lds((const unsigned*)(src + i * 1024), (LAS unsigned*)(lds + STASH_OFF + wid * 2048 + i * 1024), 16, 0, 0);
    }
    __device__ __forceinline__ void epi(const f32x4 (&acc)[2][2][4][2], const Unit& u, int wr, int wc, int fr, int fq, LAS unsigned char* lds) const {
        const int ch0 = u.pn * 128 + wc * 32 + 8 * fq;
        { const int t = threadIdx.x;
          if (t < 256) { const LAS f32x4* sp = (const LAS f32x4*)(lds + STASH_OFF + t * 64);
              const f32x4 s0 = sp[0], s1 = sp[1], s2 = sp[2], s3 = sp[3];
              const float tot = ((s0[0] + s0[1]) + (s0[2] + s0[3])) + ((s1[0] + s1[1]) + (s1[2] + s1[3])) + ((s2[0] + s2[1]) + (s2[2] + s2[3])) + ((s3[0] + s3[1]) + (s3[2] + s3[3]));
              ((LAS float*)(lds + INVTAB_OFF))[t] = 1.0f / sqrtf(tot * (1.0f / D) + RMS_EPS); }
          asm volatile("s_waitcnt lgkmcnt(0)" ::: "memory"); __builtin_amdgcn_s_barrier(); asm volatile("" ::: "memory"); }
        float inv[2][4];
#pragma unroll
        for (int ai = 0; ai < 2; ++ai)
#pragma unroll
            for (int m = 0; m < 4; ++m) inv[ai][m] = ((const LAS float*)(lds + INVTAB_OFF))[ai * 128 + wr * 64 + m * 16 + fr];
#pragma unroll
        for (int ai = 0; ai < 2; ++ai)
#pragma unroll
            for (int m = 0; m < 4; ++m) { const int row = u.pm * 256 + ai * 128 + wr * 64 + m * 16 + fr; const float iv = inv[ai][m];
                const float c1 = iv * -1.44269504089f, iv2 = iv * iv;
                f32x4 o[2];
#pragma unroll
                for (int n = 0; n < 2; ++n) { const f32x4 g = acc[ai][0][m][n], up = acc[ai][1][m][n]; const f32x4 t = g * c1, gu = g * up;
                    f32x4 e; e[0] = __builtin_amdgcn_exp2f(t[0]); e[1] = __builtin_amdgcn_exp2f(t[1]); e[2] = __builtin_amdgcn_exp2f(t[2]); e[3] = __builtin_amdgcn_exp2f(t[3]);
                    const f32x4 d = e + 1.0f;
                    f32x4 r; r[0] = __builtin_amdgcn_rcpf(d[0]); r[1] = __builtin_amdgcn_rcpf(d[1]); r[2] = __builtin_amdgcn_rcpf(d[2]); r[3] = __builtin_amdgcn_rcpf(d[3]);
                    o[n] = gu * (r * iv2); }
                *(u32x4*)(H + (size_t)(row >> 11) * BBS + (size_t)(row & 2047) * DFF + ch0) = pack8(o[0], o[1]); }
    }
};
struct ProbGluH : ProbGlu {
    __device__ __forceinline__ bool next(int i, Unit& u) const {
        if (i != 0) return false;
        const int L = 1280 + (c & 127), w = L >> 3; u.pm = 8 * (L & 7) + (w & 7); u.pn = w >> 3; return true;
    }
    __device__ __forceinline__ const char* aptr(const Unit& u) const { return (const char*)(A + ((size_t)u.pm * 256 + (size_t)(c >> 7) * 128) * 1024); }
    __device__ __forceinline__ void epi(const f32x4 (&acc)[2][2][4][2], const Unit& u, int wr, int wc, int fr, int fq, LAS unsigned char* lds) const {
        const int ch0 = u.pn * 128 + wc * 32 + 8 * fq, hf = c >> 7;
        { const int t = threadIdx.x;
          if (t < 256) { const LAS f32x4* sp = (const LAS f32x4*)(lds + STASH_OFF + t * 64);
              const f32x4 s0 = sp[0], s1 = sp[1], s2 = sp[2], s3 = sp[3];
              const float tot = ((s0[0] + s0[1]) + (s0[2] + s0[3])) + ((s1[0] + s1[1]) + (s1[2] + s1[3])) + ((s2[0] + s2[1]) + (s2[2] + s2[3])) + ((s3[0] + s3[1]) + (s3[2] + s3[3]));
              ((LAS float*)(lds + INVTAB_OFF))[t] = 1.0f / sqrtf(tot * (1.0f / D) + RMS_EPS); }
          asm volatile("s_waitcnt lgkmcnt(0)" ::: "memory"); __builtin_amdgcn_s_barrier(); asm volatile("" ::: "memory"); }
        float inv[4];
#pragma unroll
        for (int m = 0; m < 4; ++m) inv[m] = ((const LAS float*)(lds + INVTAB_OFF))[hf * 128 + wr * 64 + m * 16 + fr];
#pragma unroll
        for (int m = 0; m < 4; ++m) { const int row = u.pm * 256 + hf * 128 + wr * 64 + m * 16 + fr; const float iv = inv[m];
            const float c1 = iv * -1.44269504089f, iv2 = iv * iv;
            f32x4 o[2];
#pragma unroll
            for (int n = 0; n < 2; ++n) { const f32x4 g = acc[0][0][m][n], up = acc[0][1][m][n]; const f32x4 t = g * c1, gu = g * up;
                f32x4 e; e[0] = __builtin_amdgcn_exp2f(t[0]); e[1] = __builtin_amdgcn_exp2f(t[1]); e[2] = __builtin_amdgcn_exp2f(t[2]); e[3] = __builtin_amdgcn_exp2f(t[3]);
                const f32x4 d = e + 1.0f;
                f32x4 r; r[0] = __builtin_amdgcn_rcpf(d[0]); r[1] = __builtin_amdgcn_rcpf(d[1]); r[2] = __builtin_amdgcn_rcpf(d[2]); r[3] = __builtin_amdgcn_rcpf(d[3]);
                o[n] = gu * (r * iv2); }
            *(u32x4*)(H + (size_t)(row >> 11) * BBS + (size_t)(row & 2047) * DFF + ch0) = pack8(o[0], o[1]); }
    }
};
}

struct Frame {
    LAS unsigned char* lds;
    volatile LAS unsigned* MISC;
    gu32* ctl;
    int tid, lane, wave, vcu, G;
    const float *x, *norm_mix_g, *norm_ffn_g, *w_in, *fnet_map, *conv_w, *conv_b, *ln_g, *ln_b, *w_out, *pool_map, *pool_scale, *w_gate, *w_up, *w_down, *final_g;
    float* out; float* ssq;
    bf16_t *WinT, *WoT, *WguT, *WdT, *PmT, *DM, *XBa, *XBb, *AT, *U, *YQ, *HID;
};

struct TrItem { const float* W; int ldw, ks0, cs0; const float* kscale; bf16_t* Dst; int ldd, dr0, dc0; };
__device__ __forceinline__ void tr_load(const TrItem& t, float (&v)[32], int lane) {
    const GAS float* src = (const GAS float*)(t.W + (size_t)t.ks0 * t.ldw + t.cs0 + lane);
#pragma unroll
    for (int i = 0; i < 32; ++i) v[i] = src[(size_t)i * t.ldw];
}
__device__ __forceinline__ void tr_store(const TrItem& t, float (&v)[32], int lane) {
    if (t.kscale) {
#pragma unroll
        for (int i = 0; i < 32; ++i) v[i] *= t.kscale[t.ks0 + i]; }
    GAS u32x4* dst = (GAS u32x4*)(t.Dst + (size_t)(t.dr0 + lane) * t.ldd + t.dc0);
#pragma unroll
    for (int c = 0; c < 4; ++c) { u32x4 o; o.x = pk2(v[8 * c + 0], v[8 * c + 1]); o.y = pk2(v[8 * c + 2], v[8 * c + 3]); o.z = pk2(v[8 * c + 4], v[8 * c + 5]); o.w = pk2(v[8 * c + 6], v[8 * c + 7]); dst[c] = o; }
}
typedef float f32x16 __attribute__((ext_vector_type(16)));
__device__ __forceinline__ void p0_fold_item(Frame& F, int item) {
    const int nb = item & 31, h = item >> 5; int tid = F.tid; asm volatile("" : "+v"(tid));
    LAS float* Ml = (LAS float*)(F.lds);
    LAS float* Wl = Ml + 128 * 129;
    LAS float* Rl = Wl + 128 * 32;
    LAS float* Tl = Rl + 128 * 32;
    const float* Mh = F.fnet_map + (size_t)h * 128 * 128;
    {
        float mv[32], wv8[8];
#pragma unroll
        for (int k = 0; k < 32; ++k) mv[k] = Mh[tid + k * (NWAVES * 64)];
#pragma unroll
        for (int k = 0; k < 8; ++k) { const int i = tid + k * (NWAVES * 64), e = i >> 5, n = i & 31; wv8[k] = F.w_out[(size_t)(h * 128 + e) * D + nb * 32 + n]; }
#pragma unroll
        for (int k = 0; k < 32; ++k) { const int i = tid + k * (NWAVES * 64), l = i >> 7, e = i & 127; Ml[l * 129 + e] = mv[k]; }
#pragma unroll
        for (int k = 0; k < 8; ++k) Wl[tid + k * (NWAVES * 64)] = wv8[k];
    }
    if (tid < 128) Tl[tid] = cospif((float)tid * (1.0f / 64.0f));
    __syncthreads();
    const int lane = tid & 63, wv = tid >> 6, li = lane & 31, lk = lane >> 5;
    if (wv < 4) {
        f32x16 acc;
#pragma unroll
        for (int i = 0; i < 16; ++i) acc[i] = 0.f;
        const LAS float* ap = Ml + (32 * wv + li) * 129 + lk; const LAS float* bp = Wl + lk * 32 + li;
#pragma unroll 8
        for (int ks = 0; ks < 64; ++ks) acc = __builtin_amdgcn_mfma_f32_32x32x2f32(ap[2 * ks], bp[2 * ks * 32], acc, 0, 0, 0);
#pragma unroll
        for (int r = 0; r < 16; ++r) Rl[(32 * wv + (r & 3) + 8 * (r >> 2) + 4 * lk) * 32 + li] = acc[r];
    }
    __syncthreads();
    {
        const int cs = wv >> 2, d = 32 * (wv & 3) + li, sh = cs ? 32 : 0;
        f32x16 acc;
#pragma unroll
        for (int i = 0; i < 16; ++i) acc[i] = 0.f;
        const LAS float* bp = Rl + lk * 32 + li;
#pragma unroll 8
        for (int ks = 0; ks < 64; ++ks) { const int l = 2 * ks + lk; acc = __builtin_amdgcn_mfma_f32_32x32x2f32(Tl[(l * d - sh) & 127], bp[2 * ks * 32], acc, 0, 0, 0); }
        const float sc = cs ? (-1.0f / 512.0f) : (1.0f / 512.0f);
        bf16_t* orow = F.WoT + (size_t)(nb * 32 + li) * KOUT + cs * 512 + h * 128 + 32 * (wv & 3) + 4 * lk;
#pragma unroll
        for (int g = 0; g < 4; ++g) { u32x2 w; w.x = pk2(acc[4 * g] * sc, acc[4 * g + 1] * sc); w.y = pk2(acc[4 * g + 2] * sc, acc[4 * g + 3] * sc); *(GAS u32x2*)(orow + 8 * g) = w; }
    }
    __syncthreads();
}
constexpr int WI_IN = 32 * 24, WI_WO = 16 * 16, WI_GU = 32 * 44, WI_D = 88 * 16, WI_PM = 4 * 8 * 4, WI_L = 2 * WI_GU + WI_D;
constexpr int WI_LT = 4096;
constexpr int WI_N0 = WI_IN + WI_WO + WI_L + WI_PM, WI_ALL = WI_N0 + WI_L;
__device__ __forceinline__ TrItem weight_desc(const Frame& F, int it) {
    int r = it;
    if (r < WI_IN) { const int kb = r / 24, cb = r % 24, c0 = 64 * cb; int dr;
        if (c0 < 512) dr = c0; else if (c0 < 1024) { const int ch = c0 - 512; dr = 512 + 256 * (ch >> 7) + (ch & 127); } else { const int ch = c0 - 1024; dr = 512 + 256 * (ch >> 7) + 128 + (ch & 127); }
        return TrItem{F.w_in, INAB, 32 * kb, c0, nullptr, F.WinT, 1024, dr, 32 * kb}; } r -= WI_IN;
    if (r < WI_WO) { const int kb = r / 16, cb = r % 16; return TrItem{F.w_out, D, 512 + 32 * kb, 64 * cb, nullptr, F.WoT, KOUT, 64 * cb, 1024 + 32 * kb}; } r -= WI_WO;
    int l = 0;
    if (r >= WI_L) { r -= WI_L;
        if (r < WI_PM) { const int g = r >> 5, q = r & 31, kb = q >> 2, cb = q & 3; return TrItem{F.pool_map + (size_t)g * 65536, 256, 32 * kb, 64 * cb, nullptr, F.PmT + (size_t)g * 65536, 256, 64 * cb, 32 * kb}; }
        r -= WI_PM; l = 1; }
    if (r < 2 * WI_GU) { const int up = r / WI_GU; r -= up * WI_GU; const int kb = r / 44, cb = r % 44, ch = 64 * cb;
        return TrItem{(up ? F.w_up : F.w_gate) + (size_t)l * D * DFF, DFF, 32 * kb, ch, F.norm_ffn_g + l * D, F.WguT + (size_t)l * 5632 * 1024, 1024, 256 * (ch >> 7) + 128 * up + (ch & 127), 32 * kb}; }
    r -= 2 * WI_GU; const int kb = r / 16, cb = r % 16;
    return TrItem{F.w_down + (size_t)l * DFF * D, D, 32 * kb, 64 * cb, nullptr, F.WdT + (size_t)l * 1024 * DFF, DFF, 64 * cb, 32 * kb};
}
constexpr int WI_P0 = WI_IN + WI_WO + WI_PM + 2 * (WI_L - WI_LT);
__device__ __forceinline__ int p0_item(int i) {
    if (i < WI_IN + WI_WO) return i; i -= WI_IN + WI_WO;
    if (i < WI_PM) return WI_IN + WI_WO + WI_L + i; i -= WI_PM;
    if (i < WI_L - WI_LT) return WI_IN + WI_WO + WI_LT + i; i -= WI_L - WI_LT;
    return WI_N0 + WI_LT + i;
}
__device__ __forceinline__ void weight_items(const Frame& F, int first, int end, int stride) {
    for (int it = first; it < end; it += 4 * stride) {
        const bool h1 = it + stride < end, h2 = it + 2 * stride < end, h3 = it + 3 * stride < end;
        const TrItem t0 = weight_desc(F, it), t1 = weight_desc(F, h1 ? it + stride : it), t2 = weight_desc(F, h2 ? it + 2 * stride : it), t3 = weight_desc(F, h3 ? it + 3 * stride : it);
        float v0[32], v1[32], v2[32], v3[32];
        tr_load(t0, v0, F.lane); if (h1) tr_load(t1, v1, F.lane); if (h2) tr_load(t2, v2, F.lane); if (h3) tr_load(t3, v3, F.lane);
        tr_store(t0, v0, F.lane); if (h1) tr_store(t1, v1, F.lane); if (h2) tr_store(t2, v2, F.lane); if (h3) tr_store(t3, v3, F.lane);
    }
}
__device__ __forceinline__ bool idle_slot(const Frame& F, int nwg, int& j, int& n) {
    const int rounds = (nwg + F.G - 1) / F.G, nbusy = nwg - (rounds - 1) * F.G, bx = (int)blockIdx.x;
    if (nbusy >= F.G) { j = bx; n = F.G; return true; }
    if (bx < nbusy) return false;
    j = bx - nbusy; n = F.G - nbusy; return true;
}
__device__ __forceinline__ void p0_prologue(Frame& F) {
    const int gw = F.vcu * NWAVES + F.wave, NGW = F.G * NWAVES;
    const int bx = (int)blockIdx.x; const bool f256 = (F.G == 256), foldwg = f256 && bx < 128;
    if (foldwg) p0_fold_item(F, bx);
    LAS float* tab = (LAS float*)F.lds;
    for (int i = F.tid; i < 2048; i += NWAVES * 64) tab[i] = cospif((float)i * (1.0f / 1024.0f));
    __syncthreads();
    const bool wi_has = gw < WI_P0;
    const TrItem wi_t = weight_desc(F, p0_item(wi_has ? gw : 0));
    float wi_v[32];
    if (wi_has) tr_load(wi_t, wi_v, F.lane);
    int didx = F.vcu * (NWAVES * 64) + F.tid; const int dstep = F.G * NWAVES * 64;
    const int it0 = f256 ? (foldwg ? bx * NWAVES + F.wave : 3072 + (bx - 128) * NWAVES + F.wave) : gw, itend = foldwg ? 3072 : BATCH * 1024, itstep = f256 ? 1024 : NGW;
    for (int it = it0; it < itend; it += itstep) {
        const int b = it >> 10, q = it & 1023, sa = q, sb = q ? (SEQ - q) : (SEQ / 2);
        const size_t ra = (size_t)(b * SEQ + sa) * D, rb = (size_t)(b * SEQ + sb) * D;
        const GAS f32x4* xr0 = (const GAS f32x4*)(F.x + ra) + F.lane;
        const GAS f32x4* xr1 = (const GAS f32x4*)(F.x + rb) + F.lane;
        const GAS f32x4* gr = (const GAS f32x4*)(F.norm_mix_g) + F.lane;
        f32x4 v0[4], v1[4], g[4]; float s0 = 0.f, s1 = 0.f;
#pragma unroll
        for (int j = 0; j < 4; ++j) { v0[j] = xr0[64 * j]; v1[j] = xr1[64 * j]; g[j] = gr[64 * j]; }
        if (didx < 4096 * 128) { const int row = didx >> 7, c0 = (didx & 127) * 8, kr = row & 2047, sh = (row >= 2048) ? 512 : 0;
            float v[8];
#pragma unroll
            for (int j = 0; j < 8; ++j) v[j] = tab[(kr * (c0 + j) - sh) & 2047];
            u32x4 w; w.x = pk2(v[0], v[1]); w.y = pk2(v[2], v[3]); w.z = pk2(v[4], v[5]); w.w = pk2(v[6], v[7]);
            *(GAS u32x4*)(F.DM + (size_t)row * 1024 + c0) = w; didx += dstep; }
#pragma unroll
        for (int j = 0; j < 4; ++j) { s0 += (v0[j].x * v0[j].x + v0[j].y * v0[j].y) + (v0[j].z * v0[j].z + v0[j].w * v0[j].w); s1 += (v1[j].x * v1[j].x + v1[j].y * v1[j].y) + (v1[j].z * v1[j].z + v1[j].w * v1[j].w); }
        const float i0 = 1.0f / sqrtf(wave_sum(s0) * (1.0f / D) + RMS_EPS), i1 = 1.0f / sqrtf(wave_sum(s1) * (1.0f / D) + RMS_EPS);
        GAS unsigned long long* o0 = (GAS unsigned long long*)(F.XBa + ra) + F.lane;
        GAS unsigned long long* o1 = (GAS unsigned long long*)(F.XBa + rb) + F.lane;
#pragma unroll
        for (int j = 0; j < 4; ++j) { const f32x4 ha = v0[j] * g[j] * i0, hb = v1[j] * g[j] * i1;
            o0[64 * j] = (unsigned long long)pk2(ha.x, ha.y) | ((unsigned long long)pk2(ha.z, ha.w) << 32);
            o1[64 * j] = (unsigned long long)pk2(hb.x, hb.y) | ((unsigned long long)pk2(hb.z, hb.w) << 32);
 }
    }
    if (wi_has) tr_store(wi_t, wi_v, F.lane);
    for (int i = gw + NGW; i < WI_P0; i += NGW) { const TrItem t = weight_desc(F, p0_item(i)); float v[32]; tr_load(t, v, F.lane); tr_store(t, v, F.lane); }
    for (; didx < 4096 * 128; didx += dstep) {
        const int row = didx >> 7, c0 = (didx & 127) * 8, kr = row & 2047, sh = (row >= 2048) ? 512 : 0;
        float v[8];
#pragma unroll
        for (int j = 0; j < 8; ++j) v[j] = tab[(kr * (c0 + j) - sh) & 2047];
        u32x4 w; w.x = pk2(v[0], v[1]); w.y = pk2(v[2], v[3]); w.z = pk2(v[4], v[5]); w.w = pk2(v[6], v[7]);
        *(GAS u32x4*)(F.DM + (size_t)row * 1024 + c0) = w;
    }
    __syncthreads();
}

__device__ __forceinline__ void conv_tile(Frame& F, int tile) {
    const int t0 = tile * 64, b = t0 >> 11, s0 = t0 & 2047; int tid = F.tid; asm volatile("" : "+v"(tid));
    const int hh = F.wave & 3, th = F.wave >> 2, c = hh * 128 + 2 * F.lane;
    f32x2 w[31];
#pragma unroll
    for (int j = 0; j < 31; ++j) w[j] = *(const GAS f32x2*)(F.conv_w + j * 512 + c);
    const f32x2 cb = *(const GAS f32x2*)(F.conv_b + c), lg = *(const GAS f32x2*)(F.ln_g + c), lb = *(const GAS f32x2*)(F.ln_b + c);
    { u32x4 sv[12];
#pragma unroll
      for (int i = 0; i < 12; ++i) { const int idx = tid + i * 512, r = idx >> 6, c16 = idx & 63, s = s0 - 15 + r;
          sv[i] = (r < 94 && s >= 0 && s < SEQ) ? *(const GAS u32x4*)(F.U + (size_t)b * BBS + (size_t)s * 512 + c16 * 8) : (u32x4){0u, 0u, 0u, 0u}; }
#pragma unroll
      for (int i = 0; i < 12; ++i) { const int idx = tid + i * 512, r = idx >> 6, c16 = idx & 63; if (r < 94) *(LAS u32x4*)(F.lds + r * 1024 + c16 * 16) = sv[i]; } }
    asm volatile("" : "+v"(w[0]), "+v"(w[30]));
    __syncthreads();
    for (int chunk = 0; chunk < 2; ++chunk) {
        const int tb = th * 32 + chunk * 16;
        unsigned pv[46];
#pragma unroll
        for (int rr = 0; rr < 46; ++rr) pv[rr] = *(const LAS unsigned*)(F.lds + (tb + rr) * 1024 + c * 2);
        f32x2 acc[16];
#pragma unroll
        for (int t = 0; t < 16; ++t) acc[t] = cb;
#pragma unroll
        for (int rr = 0; rr < 46; ++rr) {
            const f32x2 v = (f32x2){bf_lo(pv[rr]), bf_hi(pv[rr])};
#pragma unroll
            for (int t = 0; t < 16; ++t) { const int j = rr - t; if (j >= 0 && j < 31) acc[t] += w[j] * v; }
        }
        float mean[16], var[16];
#pragma unroll
        for (int t = 0; t < 16; ++t) mean[t] = wave_sum(acc[t].x + acc[t].y) * (1.0f / 128.0f);
#pragma unroll
        for (int t = 0; t < 16; ++t) { acc[t].x -= mean[t]; acc[t].y -= mean[t]; var[t] = wave_sum(acc[t].x * acc[t].x + acc[t].y * acc[t].y) * (1.0f / 128.0f); }
#pragma unroll
        for (int t = 0; t < 16; ++t) {
            const float rstd = __builtin_amdgcn_rsqf(var[t] + LN_EPS);
            const float y0 = acc[t].x * rstd * lg.x + lb.x, y1 = acc[t].y * rstd * lg.y + lb.y;
            const float o0 = y0 * fast_sigmoid(y0), o1 = y1 * fast_sigmoid(y1);
            *(GAS unsigned*)(F.YQ + (size_t)b * BBS + (size_t)(s0 + tb + t) * KOUT + 1024 + c) = pk2(o0, o1);
        }
    }
    __syncthreads();
}

__device__ __forceinline__ void pool_tile(Frame& F, int tile, const float* ssq) {
    const int tt = tile >> 2, gi = tile & 3, t0 = tt * 64, b = t0 >> 11, s0 = t0 & 2047, tid = F.tid;
    LAS float* hL = (LAS float*)F.lds;
    LAS float* invL = hL + 80 * 256;
    const bf16_t* xg = F.XBb + (size_t)b * SEQ * D + gi * 256;
    u32x4 xv[5];
#pragma unroll
    for (int i = 0; i < 5; ++i) { const int e = tid + i * 512, r = e >> 5, c8 = e & 31, s = s0 - 8 + r;
        xv[i] = (s >= 0 && s < SEQ) ? *(const GAS u32x4*)(xg + (size_t)s * D + c8 * 8) : (u32x4){0u, 0u, 0u, 0u}; }
    if (tid < 80) { const int s = s0 - 8 + tid; float inv = 0.f;
        if (s >= 0 && s < SEQ) { const GAS f32x4* sp = (const GAS f32x4*)(ssq + (size_t)(b * SEQ + s) * 16); const f32x4 a = sp[0], bq = sp[1], cq = sp[2], dq = sp[3];
            const float tot = ((a[0] + a[1]) + (a[2] + a[3])) + ((bq[0] + bq[1]) + (bq[2] + bq[3])) + ((cq[0] + cq[1]) + (cq[2] + cq[3])) + ((dq[0] + dq[1]) + (dq[2] + dq[3]));
            inv = 1.0f / sqrtf(tot * (1.0f / D) + RMS_EPS); }
        invL[tid] = inv; }
    __syncthreads();
    { const f32x4 ga = *(const GAS f32x4*)(F.norm_mix_g + D + gi * 256 + (tid & 31) * 8), gb = *(const GAS f32x4*)(F.norm_mix_g + D + gi * 256 + (tid & 31) * 8 + 4);
#pragma unroll
      for (int i = 0; i < 5; ++i) { const int e = tid + i * 512, r = e >> 5, c8 = e & 31; const u32x4 h = xv[i]; const float iv = invL[r];
          *(LAS f32x4*)(hL + r * 256 + c8 * 8) = (f32x4){bf_lo(h.x), bf_hi(h.x), bf_lo(h.y), bf_hi(h.y)} * ga * iv;
          *(LAS f32x4*)(hL + r * 256 + c8 * 8 + 4) = (f32x4){bf_lo(h.z), bf_hi(h.z), bf_lo(h.w), bf_hi(h.w)} * gb * iv; } }
    __syncthreads();
    const int cp = tid & 127, tq = tid >> 7, w = 2 << gi, half = w >> 1;
    const LAS f32x2* hp = (const LAS f32x2*)hL + cp;
    const int i0 = tq * 16;
    f32x2 S = (f32x2){0.f, 0.f};
    for (int r = i0 + 8 - half; r < i0 + 8 - half + w; ++r) S += hp[r * 128];
    bf16_t* orow = F.XBa + (size_t)(b * SEQ + s0 + i0) * D + gi * 256 + cp * 2;
    for (int i = 0; i < 16; ++i) {
        const int t = s0 + i0 + i, r = i0 + i + 8; const int lo = (t - half) < 0 ? 0 : (t - half), hi = (t - half + w) > SEQ ? SEQ : (t - half + w);
        const float rc = 1.0f / (float)(hi - lo);
        const f32x2 h = hp[r * 128];
        const f32x2 pg = S * rc - h;
        *(GAS unsigned*)(orow + (size_t)i * D) = pk2(pg.x, pg.y);
        S += hp[(r - half + w) * 128]; S -= hp[(r - half) * 128];
    }
    __syncthreads();
}

__device__ __forceinline__ void poolmix_phase(Frame& F, const float* ssq_in, float* ssq_out, int tile0, int tstep, int tcount) {
    int tid = F.tid; asm volatile("" : "+v"(tid));
    LAS float* hL = (LAS float*)F.lds;
    LAS float* invL = hL + 80 * 256;
    LAS unsigned char* pgL = F.lds + 82432;
    LAS float* partL = (LAS float*)(F.lds + 82432 + 32768);
    const int lane = tid & 63, wv = F.wave, fr = lane & 15, fq = lane >> 4;
    const int ntile = 4 * (MTOK / 64);
    int tile = tile0; if (tile >= ntile || tcount <= 0) return;
    const int gi = tile & 3; const bool same_g = (tstep & 3) == 0;
    bf16x8 Bf[2][8];
#define PM_LOAD_B(g_) do { const bf16_t* pm_ = F.PmT + (size_t)(g_) * 65536; _Pragma("unroll") for (int nt = 0; nt < 2; ++nt) { const bf16_t* rp_ = pm_ + (size_t)(32 * wv + pg8::perm32(16 * nt + fr)) * 256 + 8 * fq; \
        _Pragma("unroll") for (int ks = 0; ks < 8; ++ks) Bf[nt][ks] = *(const GAS bf16x8*)(rp_ + 32 * ks); } } while (0)
    PM_LOAD_B(gi);
    u32x4 xv[5];
#define PM_LOAD_X(tl_) do { const int tt_ = (tl_) >> 2, g_ = (tl_) & 3, t0_ = tt_ * 64, b_ = t0_ >> 11, s0_ = t0_ & 2047; const bf16_t* xg_ = F.XBb + (size_t)b_ * SEQ * D + g_ * 256; \
        _Pragma("unroll") for (int i = 0; i < 5; ++i) { const int e = tid + i * 512, r = e >> 5, c8 = e & 31, s = s0_ - 8 + r; \
            xv[i] = (s >= 0 && s < SEQ) ? *(const GAS u32x4*)(xg_ + (size_t)s * D + c8 * 8) : (u32x4){0u, 0u, 0u, 0u}; } } while (0)
    PM_LOAD_X(tile);
    for (int tk = 0; tk < tcount && tile < ntile; ++tk, tile += tstep) {
        const int g = tile & 3, tt = tile >> 2, t0 = tt * 64, b = t0 >> 11, s0 = t0 & 2047;
        if (!same_g) PM_LOAD_B(g);
        if (tid < 80) { const int s = s0 - 8 + tid; float inv = 0.f;
            if (s >= 0 && s < SEQ) { const GAS f32x4* sp = (const GAS f32x4*)(ssq_in + (size_t)(b * SEQ + s) * 16); const f32x4 a = sp[0], bq = sp[1], cq = sp[2], dq = sp[3];
                const float tot = ((a[0] + a[1]) + (a[2] + a[3])) + ((bq[0] + bq[1]) + (bq[2] + bq[3])) + ((cq[0] + cq[1]) + (cq[2] + cq[3])) + ((dq[0] + dq[1]) + (dq[2] + dq[3]));
                inv = 1.0f / sqrtf(tot * (1.0f / D) + RMS_EPS); }
            invL[tid] = inv; }
        __syncthreads();
        { const f32x4 ga = *(const GAS f32x4*)(F.norm_mix_g + D + g * 256 + (tid & 31) * 8), gb = *(const GAS f32x4*)(F.norm_mix_g + D + g * 256 + (tid & 31) * 8 + 4);
#pragma unroll
          for (int i = 0; i < 5; ++i) { const int e = tid + i * 512, r = e >> 5, c8 = e & 31; const u32x4 h = xv[i]; const float iv = invL[r];
              *(LAS f32x4*)(hL + r * 256 + c8 * 8) = (f32x4){bf_lo(h.x), bf_hi(h.x), bf_lo(h.y), bf_hi(h.y)} * ga * iv;
              *(LAS f32x4*)(hL + r * 256 + c8 * 8 + 4) = (f32x4){bf_lo(h.z), bf_hi(h.z), bf_lo(h.w), bf_hi(h.w)} * gb * iv; } }
        const int col0 = g * 256 + 32 * wv + 8 * fq;
        if (tk + 1 < tcount && tile + tstep < ntile) PM_LOAD_X(tile + tstep);
        __syncthreads();
        { const int cp = tid & 127, tq = tid >> 7, w = 2 << g, half = w >> 1;
          const LAS f32x2* hp = (const LAS f32x2*)hL + cp;
          const int i0 = tq * 16;
          f32x2 S = (f32x2){0.f, 0.f};
          for (int r = i0 + 8 - half; r < i0 + 8 - half + w; ++r) S += hp[r * 128];
#pragma unroll 4
          for (int i = 0; i < 16; ++i) {
              const int tok = i0 + i, t = s0 + tok, r = tok + 8; const int lo = (t - half) < 0 ? 0 : (t - half), hi = (t - half + w) > SEQ ? SEQ : (t - half + w);
              const float rc = __builtin_amdgcn_rcpf((float)(hi - lo));
              const f32x2 h = hp[r * 128];
              const f32x2 pg = S * rc - h;
              *(LAS unsigned*)(pgL + tok * 512 + ((((cp >> 2) ^ (tok & 15))) << 4) + (cp & 3) * 4) = pk2(pg.x, pg.y);
              S += hp[(r - half + w) * 128]; S -= hp[(r - half) * 128];
          } }
        __syncthreads();
        u32x4 hx[4];
#pragma unroll
        for (int m = 0; m < 4; ++m) hx[m] = *(const GAS u32x4*)(F.XBb + (size_t)(b * SEQ + s0 + 16 * m + fr) * D + col0);
        f32x4 acc[4][2];
#pragma unroll
        for (int m = 0; m < 4; ++m)
#pragma unroll
            for (int nt = 0; nt < 2; ++nt) acc[m][nt] = (f32x4){0.f, 0.f, 0.f, 0.f};
#pragma unroll
        for (int ks = 0; ks < 8; ++ks) {
#pragma unroll
            for (int m = 0; m < 4; ++m) { const bf16x8 Af = *(const LAS bf16x8*)(pgL + (16 * m + fr) * 512 + (((4 * ks + fq) ^ fr) << 4));
#pragma unroll
                for (int nt = 0; nt < 2; ++nt) acc[m][nt] = __builtin_amdgcn_mfma_f32_16x16x32_bf16(Bf[nt][ks], Af, acc[m][nt], 0, 0, 0); }
            if (ks & 1) __builtin_amdgcn_sched_barrier(0);
        }
        { const f32x4 sc0 = *(const GAS f32x4*)(F.pool_scale + col0), sc1 = *(const GAS f32x4*)(F.pool_scale + col0 + 4);
#pragma unroll
          for (int m = 0; m < 4; ++m) { const int tok = 16 * m + fr; const size_t off = (size_t)(b * SEQ + s0 + tok) * D + col0; const u32x4 h = hx[m];
              const f32x4 o0 = (f32x4){bf_lo(h.x), bf_hi(h.x), bf_lo(h.y), bf_hi(h.y)} + sc0 * acc[m][0], o1 = (f32x4){bf_lo(h.z), bf_hi(h.z), bf_lo(h.w), bf_hi(h.w)} + sc1 * acc[m][1];
              *(GAS u32x4*)(F.XBa + off) = pg8::pack8(o0, o1);
              float sq = (o0[0] * o0[0] + o0[1] * o0[1]) + (o0[2] * o0[2] + o0[3] * o0[3]) + (o1[0] * o1[0] + o1[1] * o1[1]) + (o1[2] * o1[2] + o1[3] * o1[3]);
              sq += __shfl_xor(sq, 16); sq += __shfl_xor(sq, 32);
              if (fq == 0) partL[wv * 64 + tok] = sq; } }
        __syncthreads();
        if (tid < 256) { const int r = tid >> 2, q = tid & 3; ssq_out[(size_t)(b * SEQ + s0 + r) * 16 + g * 4 + q] = partL[(2 * q) * 64 + r] + partL[(2 * q + 1) * 64 + r]; }
    }
#undef PM_LOAD_B
#undef PM_LOAD_X
    __syncthreads();
}

struct Args { const float* in[16]; float* out; unsigned char* ws; int ph_lo, ph_hi; };
__global__ void __launch_bounds__(NWAVES * 64, 2) fwd_mega(Args args) {
    extern __shared__ __attribute__((aligned(16))) unsigned char lds[];
    Frame F;
    F.lds = (LAS unsigned char*)lds;
    F.MISC = (volatile LAS unsigned*)(F.lds + MISC_OFF);
    F.tid = threadIdx.x; F.lane = F.tid & 63; F.wave = __builtin_amdgcn_readfirstlane(F.tid >> 6);
    F.G = gridDim.x; { const int bx = blockIdx.x; F.vcu = (F.G % 8 == 0) ? (bx % 8) * (F.G / 8) + bx / 8 : bx; }
    unsigned char* ws = args.ws;
    F.ctl = (gu32*)(ws + WS_CTL);
    F.x = args.in[0]; F.norm_mix_g = args.in[1]; F.norm_ffn_g = args.in[2]; F.w_in = args.in[3]; F.fnet_map = args.in[4]; F.conv_w = args.in[5]; F.conv_b = args.in[6];
    F.ln_g = args.in[7]; F.ln_b = args.in[8]; F.w_out = args.in[9]; F.pool_map = args.in[10]; F.pool_scale = args.in[11]; F.w_gate = args.in[12]; F.w_up = args.in[13]; F.w_down = args.in[14]; F.final_g = args.in[15];
    F.out = args.out; F.ssq = (float*)(ws + WS_SSQ);
    F.WinT = (bf16_t*)(ws + WS_WIN); F.WoT = (bf16_t*)(ws + WS_WO); F.WguT = (bf16_t*)(ws + WS_WGU); F.WdT = (bf16_t*)(ws + WS_WD); F.PmT = (bf16_t*)(ws + WS_PM); F.DM = (bf16_t*)(ws + WS_DM);
    F.XBa = (bf16_t*)(ws + WS_XBA); F.XBb = (bf16_t*)(ws + WS_XBB); F.AT = (bf16_t*)(ws + WS_AT); F.U = (bf16_t*)(ws + WS_U); F.YQ = (bf16_t*)(ws + WS_YQ); F.HID = (bf16_t*)(ws + WS_HID);
    for (int u = F.tid; u < (STASH_OFF - LDSCTL_OFF) / 4; u += NWAVES * 64) ((LAS unsigned*)(F.lds + LDSCTL_OFF))[u] = 0u;
    __syncthreads();
    XcdBarrier bar; bar.bar = (unsigned*)(F.ctl + CW_BAR); bar.x = 0; bar.st = nullptr;
#if !MK_SPLIT
    bar = xcd_barrier_post((unsigned*)(F.ctl + CW_BAR), F.MISC + 8);
#endif
    const int lo = args.ph_lo, hi = args.ph_hi;
#define IN(k) (lo <= (k) && (k) < hi)
#if MK_SPLIT
#define SEAM(k) do { } while (0)
#else
#define SEAM(k) do { if (IN(k) && IN((k) + 1)) { if ((k) == 0) xcd_barrier<true>(bar); else if (MODE_LOC && ((k) == 1 || (k) == 3 || (k) == 4 || (k) == 5 || (k) == 7 || (k) == 8)) grp_barrier((unsigned*)F.ctl, LG, (unsigned)(F.G >> 3), F.MISC + 12); else xcd_barrier<false>(bar); } } while (0)
#endif
    const int bx = (int)blockIdx.x;
    const bool MODE_LOC = (F.G == 256); const unsigned LG = (unsigned)bx & 7u; const int LJ = bx >> 3;
#if !MK_SPLIT
    if (F.tid == 0) __hip_atomic_store((unsigned*)(F.ctl + CW_XID) + bx, 1u + xb_xcc_id(), __ATOMIC_RELAXED, __HIP_MEMORY_SCOPE_AGENT);
#endif
#define STAMP(k) do { if (DIAG_PH >= 0 && blockIdx.x == 0 && F.tid == 0) F.MISC[16 + (k)] = (unsigned)__builtin_amdgcn_s_memrealtime(); } while (0)
    STAMP(0);

#define REPS(k) ((PROBE_PH == (k)) ? (1 + PROBE_REP) : 1)
#define FOR_REP(k) _Pragma("unroll") for (int rep = 0, nrep = REPS(k); rep < nrep; ++rep)
#define DRY (rep + 1 < nrep)
    FOR_REP(0) { if (IN(0)) { p0_prologue(F); } SEAM(0); } STAMP(1);
#if !MK_SPLIT
    if (MODE_LOC && F.tid == 0) { const unsigned mine = 1u + xb_xcc_id(); unsigned same = 1u;
        for (int j = 0; j < 32; ++j) same &= (__hip_atomic_load((unsigned*)(F.ctl + CW_XID) + (int)LG + 8 * j, __ATOMIC_RELAXED, __HIP_MEMORY_SCOPE_AGENT) == mine) ? 1u : 0u;
        F.MISC[12] = same; }
#endif
    FOR_REP(1) {
        if (IN(1)) {
            pg8::ProbIn p; p.init(64, 6, F.G, bx); p.K = 1024; p.lda = 1024; p.ldb = 1024; p.kmult = (PROBE_KMULT_PH == 1) ? PROBE_KMULT : 1; p.X = F.XBa; p.WinT = F.WinT; p.AT = F.AT; p.U = F.U;
            pg8::gemm_phase<pg8::ProbIn, true>(F.lds, p);
            { int j, n; const bool idle = idle_slot(F, 384, j, n);
              if (idle) weight_items(F, WI_IN + WI_WO + j * NWAVES + F.wave, WI_IN + WI_WO + WI_LT, n * NWAVES);
              if (F.G == 256) { }
              else if (idle && n == F.G) { for (int it = j; it < 128; it += n) p0_fold_item(F, it); }
              else if (!idle) { const int nbusy = 384 - ((384 + F.G - 1) / F.G - 1) * F.G; for (int it = bx; it < 128; it += nbusy) p0_fold_item(F, it); } }
        }
        SEAM(1); } STAMP(2);
    FOR_REP(2) {
        if (IN(2)) {
            pg8::ProbDft p; p.init(16, 16, F.G, bx); p.K = 1024; p.lda = 1024; p.ldb = 1024; p.DM = F.DM; p.AT = F.AT; p.YQ = F.YQ; p.loc = MODE_LOC; p.lg = (int)LG; p.lj = LJ; p.mult = PROBE_DFT_MULT; p.kmult = (PROBE_KMULT_PH == 2) ? PROBE_KMULT : 1;
            pg8::gemm_phase<pg8::ProbDft, true>(F.lds, p);
            if (MODE_LOC) conv_tile(F, (int)LG * 32 + LJ);
            else for (int t = F.vcu; t < PROBE_CONV_MULT * (MTOK / 64); t += F.G) conv_tile(F, t % (MTOK / 64));
        }
        SEAM(2); } STAMP(3);
    FOR_REP(3) {
        if (IN(3)) {
            pg8::ProbRes<false, false, true> p; p.init(64, 4, F.G, bx); p.kmult = (PROBE_KMULT_PH == 3) ? PROBE_KMULT : 1; p.K = KOUT; p.lda = KOUT; p.ldb = KOUT; p.A = F.YQ; p.Bt = F.WoT; p.a_bs = BBS; p.a_pm = (size_t)256 * KOUT; p.a_pn = 0; p.b_pn = (size_t)256 * KOUT;
            p.base = F.x; p.out = F.XBb; p.scale = nullptr; p.ssq = F.ssq;
            pg8::gemm_phase<pg8::ProbRes<false, false, true>, true>(F.lds, p);
        }
        SEAM(3); } STAMP(4);
#pragma unroll
    for (int l = 0; l < 2; ++l) {
        const int pb = l ? 7 : 4;
        FOR_REP(pb) {
            if (IN(pb)) {
                pg8::ProbGlu p; p.init(64, 22, F.G, bx); p.kmult = (PROBE_KMULT_PH == pb) ? PROBE_KMULT : 1; p.K = 1024; p.lda = 1024; p.ldb = 1024; p.A = l ? F.XBa : F.XBb; p.Bt = F.WguT + (size_t)l * 5632 * 1024; p.ssq = F.ssq + (size_t)(2 * l) * MTOK * 16; p.H = F.HID;
                const bool hm = MODE_LOC && l == 1;
                if (hm) p.nwg = 1280;
                pg8::gemm_phase<pg8::ProbGlu, true>(F.lds, p);
                if (hm) { pg8::ProbGluH q; q.init(64, 22, F.G, bx); q.K = 1024; q.lda = 1024; q.ldb = 1024; q.A = p.A; q.Bt = p.Bt; q.ssq = p.ssq; q.H = p.H;
                          pg8::gemm_phase<pg8::ProbGluH, true, true>(F.lds, q); }
                if (l == 0) { int j, n; if (idle_slot(F, 64 * 22, j, n)) weight_items(F, WI_N0 + j * NWAVES + F.wave, WI_N0 + WI_LT, n * NWAVES); }
            }
            SEAM(pb); } STAMP(pb + 1);
        FOR_REP(pb + 1) {
            if (IN(pb + 1)) {
                if (l == 0) {
                    pg8::ProbRes<false, true, true> p; p.init(64, 4, F.G, bx); p.kmult = (PROBE_KMULT_PH == pb + 1) ? PROBE_KMULT : 1; p.K = DFF; p.lda = DFF; p.ldb = DFF; p.A = F.HID; p.Bt = F.WdT; p.a_bs = BBS; p.a_pm = (size_t)256 * DFF; p.a_pn = 0; p.b_pn = (size_t)256 * DFF;
                    p.base = F.XBb; p.out = DRY ? (void*)(ws + WS_END) : (void*)F.XBb; p.scale = nullptr; p.ssq = DRY ? (float*)(ws + WS_END + 32 * MiB) : F.ssq + (size_t)1 * MTOK * 16;
                    pg8::gemm_phase<pg8::ProbRes<false, true, true>, true>(F.lds, p);
                } else {
                    pg8::ProbRes<false, true, true> p; p.init(64, 4, F.G, bx); p.kmult = (PROBE_KMULT_PH == pb + 1) ? PROBE_KMULT : 1; p.K = DFF; p.lda = DFF; p.ldb = DFF; p.A = F.HID; p.Bt = F.WdT + (size_t)1024 * DFF; p.a_bs = BBS; p.a_pm = (size_t)256 * DFF; p.a_pn = 0; p.b_pn = (size_t)256 * DFF;
                    p.base = F.XBa; p.out = DRY ? (void*)(ws + WS_END) : (void*)F.XBa; p.scale = nullptr; p.ssq = DRY ? (float*)(ws + WS_END + 32 * MiB) : F.ssq + (size_t)3 * MTOK * 16;
                    pg8::gemm_phase<pg8::ProbRes<false, true, true>, true>(F.lds, p);
                }
            }
            SEAM(pb + 1); } STAMP(pb + 2);
        if (l == 0) {
            FOR_REP(6) { if (IN(6)) { if (MODE_LOC) poolmix_phase(F, F.ssq + (size_t)1 * MTOK * 16, F.ssq + (size_t)2 * MTOK * 16, 4 * (32 * (int)LG + (LJ >> 2)) + (LJ & 3), 32, 4);
                else poolmix_phase(F, F.ssq + (size_t)1 * MTOK * 16, F.ssq + (size_t)2 * MTOK * 16, F.vcu, F.G, 4 * (MTOK / 64)); } SEAM(6); } STAMP(7);
        }
    }
    FOR_REP(9) {
        if (IN(9)) {
            const float* ssq = F.ssq + (size_t)3 * MTOK * 16;
            float* dst = DRY ? (float*)(ws + WS_XBA) : F.out;
            const int gw = MODE_LOC ? LJ * NWAVES + F.wave : F.vcu * NWAVES + F.wave, NGW = MODE_LOC ? 256 : F.G * NWAVES, mlo = MODE_LOC ? (int)LG * SEQ : 0, mhi = MODE_LOC ? mlo + SEQ : MTOK;
            float dA = 0.f;
            if (DIAG_PH >= 0 && blockIdx.x == 0) { __syncthreads(); dA = (float)(F.MISC[16 + DIAG_PH + 1] - F.MISC[16 + DIAG_PH]) * 0.01f * DIAG_SCALE; }
            for (int m = mlo + gw; m < mhi; m += 2 * NGW) {
                const int m1 = (m + NGW < mhi) ? m + NGW : m;
                const GAS u32x4* xr0 = (const GAS u32x4*)(F.XBa + (size_t)m * D) + F.lane;
                const GAS u32x4* xr1 = (const GAS u32x4*)(F.XBa + (size_t)m1 * D) + F.lane;
                const float* gr = F.final_g + 8 * F.lane;
                u32x4 h0[2], h1[2]; f32x4 g[2][2];
#pragma unroll
                for (int j = 0; j < 2; ++j) { h0[j] = xr0[64 * j]; h1[j] = xr1[64 * j]; g[j][0] = *(const GAS f32x4*)(gr + 512 * j); g[j][1] = *(const GAS f32x4*)(gr + 512 * j + 4); }
                const float pv0 = (F.lane < 16) ? ssq[(size_t)m * 16 + F.lane] : 0.f, pv1 = (F.lane < 16) ? ssq[(size_t)m1 * 16 + F.lane] : 0.f;
                const float inv0 = 1.0f / sqrtf(wave_sum(pv0) * (1.0f / D) + RMS_EPS), inv1 = 1.0f / sqrtf(wave_sum(pv1) * (1.0f / D) + RMS_EPS);
                float* y0 = dst + (size_t)m * D + 8 * F.lane; float* y1 = dst + (size_t)m1 * D + 8 * F.lane;
#pragma unroll
                for (int j = 0; j < 2; ++j) {
                    f32x4 o0 = (f32x4){bf_lo(h0[j].x), bf_hi(h0[j].x), bf_lo(h0[j].y), bf_hi(h0[j].y)} * inv0 * g[j][0]; const f32x4 o1 = (f32x4){bf_lo(h0[j].z), bf_hi(h0[j].z), bf_lo(h0[j].w), bf_hi(h0[j].w)} * inv0 * g[j][1];
                    if (DIAG_PH >= 0 && m == 0 && F.lane == 0 && j == 0) o0.x += dA;
                    *(GAS f32x4*)(y0 + 512 * j) = o0; *(GAS f32x4*)(y0 + 512 * j + 4) = o1;
                    if (m1 != m) { *(GAS f32x4*)(y1 + 512 * j) = (f32x4){bf_lo(h1[j].x), bf_hi(h1[j].x), bf_lo(h1[j].y), bf_hi(h1[j].y)} * inv1 * g[j][0];
                                   *(GAS f32x4*)(y1 + 512 * j + 4) = (f32x4){bf_lo(h1[j].z), bf_hi(h1[j].z), bf_lo(h1[j].w), bf_hi(h1[j].w)} * inv1 * g[j][1]; } }
            }
        }
        if (DRY) { if (IN(9)) xcd_barrier<false>(bar); } }
#undef REPS
#undef FOR_REP
#undef DRY
#undef IN
#undef SEAM
}

extern "C" void kernel_launch(void* const* d_in, const int* in_sizes, int n_in, void* d_out, int out_size, void* d_ws, size_t ws_size, hipStream_t stream) {
    static int grid = 0;
    if (grid == 0) {
        if (n_in != 16 || in_sizes[0] != MTOK * D || out_size != MTOK * D || ws_size < WS_END) { fprintf(stderr, "kernel_launch: unexpected shapes (n_in %d, in0 %d, out %d, ws %zu)\n", n_in, n_in > 0 ? in_sizes[0] : -1, out_size, ws_size); grid = -1; return; }
        int dev = 0, cus = 0, per_cu = 0;
        if (hipGetDevice(&dev) != hipSuccess || hipDeviceGetAttribute(&cus, hipDeviceAttributeMultiprocessorCount, dev) != hipSuccess) { grid = -1; return; }
        if (hipFuncSetAttribute((const void*)fwd_mega, hipFuncAttributeMaxDynamicSharedMemorySize, LDS_BYTES) != hipSuccess) { fprintf(stderr, "kernel_launch: hipFuncSetAttribute failed\n"); grid = -1; return; }
        if (hipOccupancyMaxActiveBlocksPerMultiprocessor(&per_cu, (const void*)fwd_mega, NWAVES * 64, LDS_BYTES) != hipSuccess || per_cu < 1) { fprintf(stderr, "kernel_launch: occupancy query says %d blocks/CU\n", per_cu); per_cu = 1; }
        (void)hipGetLastError();
        grid = cus;
    }
    if (grid < 0) return;
    if (hipMemsetAsync((char*)d_ws + WS_CTL, 0, CTL_ZERO_BYTES, stream) != hipSuccess) { fprintf(stderr, "kernel_launch: memset failed\n"); return; }
    Args a{};
    for (int i = 0; i < 16; ++i) a.in[i] = (const float*)d_in[i];
    a.out = (float*)d_out; a.ws = (unsigned char*)d_ws;
#if MK_SPLIT
    for (int ph = 0; ph < N_PHASES; ++ph) { a.ph_lo = ph; a.ph_hi = ph + 1; hipLaunchKernelGGL(fwd_mega, dim3(grid), dim3(NWAVES * 64), LDS_BYTES, stream, a); }
#else
    a.ph_lo = 0; a.ph_hi = N_PHASES;
    hipLaunchKernelGGL(fwd_mega, dim3(grid), dim3(NWAVES * 64), LDS_BYTES, stream, a);
#endif
    const hipError_t le = hipPeekAtLastError();
    if (le != hipSuccess) fprintf(stderr, "kernel_launch: launch failed: %s\n", hipGetErrorName(le));
}
```
